# Optimizing an MI355X kernel written in HIP

```python
import jax, jax.numpy as jnp
from jax import lax
import numpy as np

D_MODEL = 1024
BATCH = 32
SEQ = 2048
DEPTH = 4
DEC_BATCH = 32
DEC_SEQ = 32
PAST_LEN = 1024

CHUNK = 64
HEAD_DIM = 64
ROPE_THETA = 500000.0
NORM_EPS = 1e-6
NEG_INF = -1e30
Q_BLOCK = 128
A_HEADS = 8
A_Q_LORA = 256
A_KV_LORA = 128
A_NOPE = 64
A_ROPE = 32
A_QK = A_NOPE + A_ROPE
A_V = 64
A_SCALE = A_QK ** -0.5
B_HEADS = 8
B_BACK_CHUNKS = 8
B_REACH = B_BACK_CHUNKS * CHUNK
B_MAX_REL = 128
C_HEADS = 16
C_KV_HEADS = 2
C_WINDOW = 128
C_ROT = HEAD_DIM // 4
HEAD_SCALE = HEAD_DIM ** -0.5
D_FF = 2816
N_EVEN = (DEPTH + 1) // 2
N_ODD = DEPTH // 2
EVEN_IN = A_Q_LORA + A_KV_LORA + A_ROPE + 3 * B_HEADS * HEAD_DIM
MIX_EVEN = A_HEADS * A_V + B_HEADS * HEAD_DIM
ODD_IN = (C_HEADS + 2 * C_KV_HEADS) * HEAD_DIM
MIX_ODD = C_HEADS * HEAD_DIM

kernel_name = "hybrid_streaming_encoder_step"


def rms_norm(x, g):
    xf = x.astype(jnp.float32)
    y = xf * lax.rsqrt(jnp.mean(xf * xf, axis=-1, keepdims=True) + NORM_EPS)
    return (y * g.astype(jnp.float32)).astype(x.dtype)


def rope(x, pos, n_rot):
    half = n_rot // 2
    inv = ROPE_THETA ** (-jnp.arange(half, dtype=jnp.float32) / half)
    ang = pos.astype(jnp.float32)[:, None] * inv[None, :]
    cos = jnp.cos(ang)[:, None, :]
    sin = jnp.sin(ang)[:, None, :]
    xf = x.astype(jnp.float32)
    x1, x2 = xf[..., :half], xf[..., half:n_rot]
    out = jnp.concatenate([x1 * cos - x2 * sin, x2 * cos + x1 * sin, xf[..., n_rot:]], axis=-1)
    return out.astype(x.dtype)


def swiglu(x, w_gate, w_up, w_down):
    a = jnp.einsum('btd,df->btf', x, w_gate)
    b = jnp.einsum('btd,df->btf', x, w_up)
    return jnp.einsum('btf,fd->btd', jax.nn.silu(a) * b, w_down)


def attn_probs(s, mask, sink=None):
    s = jnp.where(mask, s, NEG_INF)
    if sink is not None:
        sk = jnp.broadcast_to(sink.astype(jnp.float32)[None, :, None, None], s.shape[:-1] + (1,))
        return jax.nn.softmax(jnp.concatenate([s, sk], axis=-1), axis=-1)[..., :-1]
    return jax.nn.softmax(s, axis=-1)


def mla_attend(qn, qp, k_nope, kpe, v, mask):
    b, q = qn.shape[:2]
    s = jnp.einsum('bqhd,bkhd->bhqk', qn, k_nope) + jnp.einsum('bqhd,bkd->bhqk', qp, kpe)
    p = attn_probs(s.astype(jnp.float32) * A_SCALE, mask)
    return jnp.einsum('bhqk,bkhd->bqhd', p.astype(v.dtype), v).reshape(b, q, A_HEADS * A_V)


def mla_prompt(qn, qp, k_nope, kpe, v):
    b, s_len = qn.shape[:2]
    key_chunk = jnp.arange(s_len) // CHUNK

    def one_block(i):
        start = i * Q_BLOCK
        qnb = lax.dynamic_slice_in_dim(qn, start, Q_BLOCK, axis=1)
        qpb = lax.dynamic_slice_in_dim(qp, start, Q_BLOCK, axis=1)
        q_chunk = (start + jnp.arange(Q_BLOCK)) // CHUNK
        mask = key_chunk[None, :] <= q_chunk[:, None]
        return mla_attend(qnb, qpb, k_nope, kpe, v, mask)

    out = lax.map(one_block, jnp.arange(s_len // Q_BLOCK))
    return jnp.moveaxis(out, 0, 1).reshape(b, s_len, -1)


def band_attend(q, k, v, q_pos, k_pos, rel_table):
    b, nq, h, d = q.shape
    rel = jnp.clip(q_pos[:, None] - k_pos[None, :], -B_MAX_REL, B_MAX_REL) + B_MAX_REL
    bias = rel_table.astype(jnp.float32)[:, rel]
    s = jnp.einsum('bqhd,bkhd->bhqk', q, k).astype(jnp.float32) * HEAD_SCALE + bias[None]
    p = attn_probs(s, (k_pos >= 0)[None, :])
    return jnp.einsum('bhqk,bkhd->bqhd', p.astype(v.dtype), v).reshape(b, nq, h * d)


def swa_attend(q, k, v, k_pos, sinks):
    b, nq, h, d = q.shape
    kvh = k.shape[2]
    g = h // kvh
    nk = k.shape[1]
    qg = q.reshape(b, nq, kvh, g, d)
    s = jnp.einsum('bqkgd,bskd->bkgqs', qg, k).astype(jnp.float32).reshape(b, h, nq, nk) * HEAD_SCALE
    p = attn_probs(s, (k_pos >= 0)[None, :], sinks).reshape(b, kvh, g, nq, nk)
    return jnp.einsum('bkgqs,bskd->bqkgd', p.astype(v.dtype), v).reshape(b, nq, h * d)


def sweep_chunks(attend, q, k, v, reach):
    b, s_len = q.shape[:2]
    pad = ((0, 0), (reach, 0), (0, 0), (0, 0))
    kp, vp = jnp.pad(k, pad), jnp.pad(v, pad)
    band = reach + CHUNK

    def one_chunk(c):
        start = c * CHUNK
        qc = lax.dynamic_slice_in_dim(q, start, CHUNK, axis=1)
        kc = lax.dynamic_slice_in_dim(kp, start, band, axis=1)
        vc = lax.dynamic_slice_in_dim(vp, start, band, axis=1)
        q_pos = start + jnp.arange(CHUNK)
        k_pos = start - reach + jnp.arange(band)
        return attend(qc, kc, vc, q_pos, k_pos)

    out = lax.map(one_chunk, jnp.arange(s_len // CHUNK))
    return jnp.moveaxis(out, 0, 1).reshape(b, s_len, -1)


def even_mixer(h, pos, i, w, cache):
    b, t, _ = h.shape
    proj = jnp.einsum('btd,dc->btc', h, w['even_w_in'][i])
    c0 = A_Q_LORA
    c1 = c0 + A_KV_LORA
    c2 = c1 + A_ROPE
    cq = rms_norm(proj[..., :c0], w['mla_q_norm'][i])
    ckv = rms_norm(proj[..., c0:c1], w['mla_kv_norm'][i])
    kpe = rope(proj[:, :, None, c1:c2], pos, A_ROPE)[:, :, 0, :]
    qkv_b = proj[..., c2:].reshape(b, t, 3, B_HEADS, HEAD_DIM)
    q_b, k_b, v_b = qkv_b[:, :, 0], qkv_b[:, :, 1], qkv_b[:, :, 2]
    q_a = jnp.einsum('btr,rc->btc', cq, w['mla_w_uq'][i]).reshape(b, t, A_HEADS, A_QK)
    qn = q_a[..., :A_NOPE]
    qp = rope(q_a[..., A_NOPE:], pos, A_ROPE)
    w_ukv = w['mla_w_ukv'][i]
    rel_table = w['band_rel_bias'][i]
    band_fn = lambda qc, kc, vc, qpos, kpos: band_attend(qc, kc, vc, qpos, kpos, rel_table)
    if cache is None:
        kv = jnp.einsum('btr,rc->btc', ckv, w_ukv).reshape(b, t, A_HEADS, A_NOPE + A_V)
        out_a = mla_prompt(qn, qp, kv[..., :A_NOPE], kpe, kv[..., A_NOPE:])
        out_b = sweep_chunks(band_fn, q_b, k_b, v_b, B_REACH)
        keep = min(B_REACH, t)
        new = (ckv, kpe, k_b[:, t - keep:], v_b[:, t - keep:])
    else:
        c_ckv, c_kpe, c_k, c_v = cache
        ckv_all = jnp.concatenate([c_ckv, ckv], axis=1)
        kpe_all = jnp.concatenate([c_kpe, kpe], axis=1)
        n_all = ckv_all.shape[1]
        kv = jnp.einsum('btr,rc->btc', ckv_all, w_ukv).reshape(b, n_all, A_HEADS, A_NOPE + A_V)
        out_a = mla_attend(qn, qp, kv[..., :A_NOPE], kpe_all, kv[..., A_NOPE:], jnp.ones((t, n_all), bool))
        nb = c_k.shape[1]
        k_pos = pos[0] - nb + jnp.arange(nb + t)
        out_b = band_fn(q_b, jnp.concatenate([c_k, k_b], axis=1), jnp.concatenate([c_v, v_b], axis=1), pos, k_pos)
        new = (ckv, kpe, k_b, v_b)
    out = jnp.concatenate([out_a, out_b], axis=-1)
    return jnp.einsum('btc,cd->btd', out, w['even_w_out'][i]), new


def odd_mixer(h, pos, i, w, cache):
    b, t, _ = h.shape
    proj = jnp.einsum('btd,dc->btc', h, w['odd_w_in'][i])
    nq = C_HEADS * HEAD_DIM
    nk = C_KV_HEADS * HEAD_DIM
    q = rope(proj[..., :nq].reshape(b, t, C_HEADS, HEAD_DIM), pos, C_ROT)
    k = rope(proj[..., nq:nq + nk].reshape(b, t, C_KV_HEADS, HEAD_DIM), pos, C_ROT)
    v = proj[..., nq + nk:].reshape(b, t, C_KV_HEADS, HEAD_DIM)
    sinks = w['swa_sinks'][i]
    swa_fn = lambda qc, kc, vc, qpos, kpos: swa_attend(qc, kc, vc, kpos, sinks)
    if cache is None:
        out = sweep_chunks(swa_fn, q, k, v, C_WINDOW)
        keep = min(C_WINDOW, t)
        new = (k[:, t - keep:], v[:, t - keep:])
    else:
        c_k, c_v = cache
        nc = c_k.shape[1]
        k_pos = pos[0] - nc + jnp.arange(nc + t)
        out = swa_fn(q, jnp.concatenate([c_k, k], axis=1), jnp.concatenate([c_v, v], axis=1), pos, k_pos)
        new = (k, v)
    return jnp.einsum('btc,cd->btd', out, w['odd_w_out'][i]), new


def trunk(x, pos, caches, w):
    new = ([], [], [], [], [], [])
    for l in range(DEPTH):
        g = w['norm_g'][l]
        ff_a = swiglu(rms_norm(x, g[0]), w['ffn_w_gate'][l, 0], w['ffn_w_up'][l, 0], w['ffn_w_down'][l, 0])
        x = x + 0.5 * rms_norm(ff_a, g[1])
        h = rms_norm(x, g[2])
        i = l // 2
        if l % 2 == 0:
            lc = None if caches is None else (caches[0][i], caches[1][i], caches[2][i], caches[3][i])
            mix, st = even_mixer(h, pos, i, w, lc)
            for j in range(4):
                new[j].append(st[j])
        else:
            lc = None if caches is None else (caches[4][i], caches[5][i])
            mix, st = odd_mixer(h, pos, i, w, lc)
            new[4].append(st[0])
            new[5].append(st[1])
        x = x + rms_norm(mix, g[3])
        ff_b = swiglu(rms_norm(x, g[4]), w['ffn_w_gate'][l, 1], w['ffn_w_up'][l, 1], w['ffn_w_down'][l, 1])
        x = x + 0.5 * rms_norm(ff_b, g[5])
    return x, [jnp.stack(s, axis=0) for s in new]


def setup_inputs(seed: int = 0) -> dict:
    key = jax.random.key(seed)
    ks = jax.random.split(key, 22)
    nrm = lambda k, shape, s: jax.random.normal(k, shape, jnp.float32) * s
    b_cache = min(B_REACH, PAST_LEN)
    c_cache = min(C_WINDOW, PAST_LEN)
    return {
        'x_prompt': nrm(ks[0], (BATCH, SEQ, D_MODEL), 1.0),
        'x_sample': nrm(ks[1], (DEC_BATCH, DEC_SEQ, D_MODEL), 1.0),
        'cache_mla_ckv': nrm(ks[2], (N_EVEN, DEC_BATCH, PAST_LEN, A_KV_LORA), 1.0),
        'cache_mla_kpe': nrm(ks[3], (N_EVEN, DEC_BATCH, PAST_LEN, A_ROPE), 1.0),
        'cache_band_k': nrm(ks[4], (N_EVEN, DEC_BATCH, b_cache, B_HEADS, HEAD_DIM), 1.0),
        'cache_band_v': nrm(ks[5], (N_EVEN, DEC_BATCH, b_cache, B_HEADS, HEAD_DIM), 1.0),
        'cache_swa_k': nrm(ks[6], (N_ODD, DEC_BATCH, c_cache, C_KV_HEADS, HEAD_DIM), 1.0),
        'cache_swa_v': nrm(ks[7], (N_ODD, DEC_BATCH, c_cache, C_KV_HEADS, HEAD_DIM), 1.0),
        'norm_g': 1.0 + nrm(ks[8], (DEPTH, 6, D_MODEL), 0.02),
        'ffn_w_gate': nrm(ks[9], (DEPTH, 2, D_MODEL, D_FF), D_MODEL ** -0.5),
        'ffn_w_up': nrm(ks[10], (DEPTH, 2, D_MODEL, D_FF), D_MODEL ** -0.5),
        'ffn_w_down': nrm(ks[11], (DEPTH, 2, D_FF, D_MODEL), D_FF ** -0.5),
        'even_w_in': nrm(ks[12], (N_EVEN, D_MODEL, EVEN_IN), D_MODEL ** -0.5),
        'mla_q_norm': 1.0 + nrm(ks[13], (N_EVEN, A_Q_LORA), 0.02),
        'mla_w_uq': nrm(ks[14], (N_EVEN, A_Q_LORA, A_HEADS * A_QK), A_Q_LORA ** -0.5),
        'mla_kv_norm': 1.0 + nrm(ks[15], (N_EVEN, A_KV_LORA), 0.02),
        'mla_w_ukv': nrm(ks[16], (N_EVEN, A_KV_LORA, A_HEADS * (A_NOPE + A_V)), A_KV_LORA ** -0.5),
        'band_rel_bias': nrm(ks[17], (N_EVEN, B_HEADS, 2 * B_MAX_REL + 1), 0.5),
        'even_w_out': nrm(ks[18], (N_EVEN, MIX_EVEN, D_MODEL), MIX_EVEN ** -0.5),
        'odd_w_in': nrm(ks[19], (N_ODD, D_MODEL, ODD_IN), D_MODEL ** -0.5),
        'swa_sinks': nrm(ks[20], (N_ODD, C_HEADS), 1.0),
        'odd_w_out': nrm(ks[21], (N_ODD, MIX_ODD, D_MODEL), MIX_ODD ** -0.5),
    }


def reference(x_prompt, x_sample, cache_mla_ckv, cache_mla_kpe, cache_band_k, cache_band_v,
              cache_swa_k, cache_swa_v, norm_g, ffn_w_gate, ffn_w_up, ffn_w_down, even_w_in,
              mla_q_norm, mla_w_uq, mla_kv_norm, mla_w_ukv, band_rel_bias, even_w_out,
              odd_w_in, swa_sinks, odd_w_out):
    w = dict(norm_g=norm_g, ffn_w_gate=ffn_w_gate, ffn_w_up=ffn_w_up, ffn_w_down=ffn_w_down,
             even_w_in=even_w_in, mla_q_norm=mla_q_norm, mla_w_uq=mla_w_uq, mla_kv_norm=mla_kv_norm,
             mla_w_ukv=mla_w_ukv, band_rel_bias=band_rel_bias, even_w_out=even_w_out,
             odd_w_in=odd_w_in, swa_sinks=swa_sinks, odd_w_out=odd_w_out)
    seq = x_prompt.shape[1]
    past = cache_mla_ckv.shape[2]
    t = x_sample.shape[1]
    pos_p = jnp.arange(seq, dtype=jnp.int32)
    pos_s = past + jnp.arange(t, dtype=jnp.int32)
    y_prompt, st_p = trunk(x_prompt, pos_p, None, w)
    caches = (cache_mla_ckv, cache_mla_kpe, cache_band_k, cache_band_v, cache_swa_k, cache_swa_v)
    y_sample, st_s = trunk(x_sample, pos_s, caches, w)
    ckv_p, kpe_p, bk_p, bv_p, sk_p, sv_p = st_p
    ckv_s, kpe_s, bk_s, bv_s, sk_s, sv_s = st_s
    return (y_prompt, y_sample, ckv_p, kpe_p, bk_p, bv_p, sk_p, sv_p, ckv_s, kpe_s, bk_s, bv_s, sk_s, sv_s)
```

```cpp
#include <hip/hip_runtime.h>
#include <hip/hip_cooperative_groups.h>
#include <cstdio>
#include <cmath>
namespace cg = cooperative_groups;

#define DI __device__ __forceinline__
#define LAS __attribute__((address_space(3)))
typedef unsigned short bf16_t;
typedef short bf16x8 __attribute__((ext_vector_type(8)));
typedef float f32x4 __attribute__((ext_vector_type(4)));
typedef float f32x2 __attribute__((ext_vector_type(2)));
typedef float f32x16 __attribute__((ext_vector_type(16)));
typedef unsigned u32x4 __attribute__((ext_vector_type(4)));
typedef unsigned u32x2 __attribute__((ext_vector_type(2)));
typedef __bf16 bf2_t __attribute__((ext_vector_type(2)));

constexpr int TP = 65536, TS = 1024, T = TP + TS;
constexpr int DM = 1024, DFF = 2816;
constexpr float EPS = 1e-6f;
constexpr float LOG2E = 1.4426950408889634f;
constexpr int NPH = 1 + 4 * 12 + 1;

constexpr size_t WS_CTL = 0;
constexpr size_t WS_ROPEA = 4096;
constexpr size_t WS_ROPEC = WS_ROPEA + 2048 * 16 * 8;
constexpr size_t WS_W = WS_ROPEC + 2048 * 8 * 8;
constexpr size_t W_FFN = 8650752, W_GU = 0, W_D = 5767168;
constexpr size_t W_EVB = 8 * W_FFN, W_EV = 4128768;
constexpr size_t WE_IN = 0, WE_INV = 2097152, WE_UQ = 2621440, WE_UK = 2818048, WE_UV = 2949120, WE_OUT = 3080192;
constexpr size_t W_ODB = W_EVB + 2 * W_EV, W_OD = 2621440;
constexpr size_t WO_IN = 0, WO_INV = 1310720, WO_OUT = 1572864;
constexpr size_t W_TOTAL = W_ODB + 2 * W_OD;
constexpr size_t WS_CKVC = WS_W + W_TOTAL * 2;
constexpr size_t WS_KPEC = WS_CKVC + (size_t)(2 * 32768 * 128 + 256) * 2;
constexpr size_t WS_VTBC = WS_KPEC + (size_t)2 * 32768 * 32 * 2;
constexpr size_t WS_VTCC = WS_VTBC + (size_t)64 * 512 * 512 * 2;
constexpr size_t WS_KNC = WS_VTCC + (size_t)64 * 128 * 128 * 2;
constexpr size_t WS_VTAC = WS_KNC + (size_t)32768 * 512 * 2;
constexpr size_t WS_HO = WS_VTAC + (size_t)32768 * 512 * 2;
constexpr size_t WS_REG = WS_HO + (size_t)T * 1024 * 2;
constexpr size_t WS_P = WS_REG;
constexpr size_t WS_QA = WS_P + (size_t)T * 2048 * 2;
constexpr size_t WS_KN = WS_QA + (size_t)T * 768 * 2;
constexpr size_t WS_VTA = WS_KN + (size_t)T * 512 * 2;
constexpr size_t WS_VTB = WS_VTA + (size_t)T * 512 * 2;
constexpr size_t WS_END = WS_VTB + (size_t)T * 512 * 2;
constexpr size_t WS_HH = WS_REG;
constexpr size_t WS_RF = WS_HH + (size_t)T * 2816 * 2;
constexpr size_t WS_RM = WS_REG;
constexpr size_t WS_RSF = WS_RF + (size_t)T * 1024 * 2;
constexpr size_t WS_RSM = WS_RM + (size_t)T * 1024 * 2;
static_assert(WS_RSF + (size_t)11 * 1024 * 1024 * 2 <= WS_END, "split region");
static_assert(WS_RF + (size_t)T * 1024 * 2 <= WS_END, "ffn region");
constexpr size_t WS_BAR = WS_END;
static_assert(WS_BAR + 16384 <= (size_t)1024 * 1024 * 1024, "workspace");

constexpr size_t O_Y = 0;
constexpr size_t O_CKVP = (size_t)T * 1024;
constexpr size_t O_KPEP = O_CKVP + (size_t)2 * 32 * 2048 * 128;
constexpr size_t O_BKP = O_KPEP + (size_t)2 * 32 * 2048 * 32;
constexpr size_t O_BVP = O_BKP + (size_t)2 * 32 * 512 * 512;
constexpr size_t O_SKP = O_BVP + (size_t)2 * 32 * 512 * 512;
constexpr size_t O_SVP = O_SKP + (size_t)2 * 32 * 128 * 128;
constexpr size_t O_CKVS = O_SVP + (size_t)2 * 32 * 128 * 128;
constexpr size_t O_KPES = O_CKVS + (size_t)2 * 32 * 32 * 128;
constexpr size_t O_BKS = O_KPES + (size_t)2 * 32 * 32 * 32;
constexpr size_t O_BVS = O_BKS + (size_t)2 * 32 * 32 * 512;
constexpr size_t O_SKS = O_BVS + (size_t)2 * 32 * 32 * 512;
constexpr size_t O_SVS = O_SKS + (size_t)2 * 32 * 32 * 128;
constexpr size_t O_END = O_SVS + (size_t)2 * 32 * 32 * 128;

struct Params {
    const float* in[22];
    float* out;
    unsigned char* ws;
    double c16, c8;
    int ph_lo, ph_hi;
};

typedef const __attribute__((address_space(4))) Params* KP;
DI unsigned pk_bf16(float lo, float hi) { f32x2 v = {lo, hi}; bf2_t r = __builtin_convertvector(v, bf2_t); return __builtin_bit_cast(unsigned, r); }
DI float bf_lo(unsigned w) { return __uint_as_float(w << 16); }
DI float bf_hi(unsigned w) { return __uint_as_float(w & 0xffff0000u); }
DI float bf2f(bf16_t b) { return __uint_as_float((unsigned)b << 16); }
DI bf16_t f2bf(float f) { return (bf16_t)(pk_bf16(f, 0.f) & 0xffffu); }
DI float wave_sum(float v) {
#pragma unroll
    for (int o = 32; o; o >>= 1) v += __shfl_xor(v, o);
    return v;
}


#define XB_TMO      128
#define XB_XCNT(j)  (256  + 64 * (j))
#define XB_XSUB(j)  (1280 + 64 * (j))
#define XB_XGEN(j)  (2304 + 64 * (j))
#define XB_TOP      3328
#define XB_TOPGEN   3392
#define XCD_BAR_WORDS 3456
#define XB_SPIN_CAP (1u << 20)
DI unsigned xb_ld(unsigned* p)              { return __hip_atomic_load(p, __ATOMIC_RELAXED, __HIP_MEMORY_SCOPE_AGENT); }
DI unsigned xb_add(unsigned* p, unsigned v) { return __hip_atomic_fetch_add(p, v, __ATOMIC_RELAXED, __HIP_MEMORY_SCOPE_AGENT); }
DI unsigned xb_xcc_id() { return (unsigned)__builtin_amdgcn_s_getreg((3 << 11) | 20) & 0xFu; }
#define XB_SPIN(cond, bar) do { unsigned _sp = 0; while (cond) { __builtin_amdgcn_s_sleep(1); \
    if ((++_sp & 255u) == 0u) { if (xb_ld(&(bar)[XB_TMO])) break; if (_sp > XB_SPIN_CAP) { atomicAdd(&(bar)[XB_TMO], 1u); break; } } } } while (0)
DI void xcd_barrier_complete(unsigned* bar, unsigned x, unsigned& nloc, unsigned& nx) {
    const unsigned G = gridDim.x;
    unsigned sum, cnt, mine, sp = 0u;
    for (;;) {
        sum = 0u; cnt = 0u; mine = 0u;
#pragma unroll
        for (unsigned j = 0; j < 16; ++j) { const unsigned c = xb_ld(&bar[XB_XCNT(j)]); sum += c; cnt += (c > 0u) ? 1u : 0u; mine = (j == x) ? c : mine; }
        if (sum == G) break;
        __builtin_amdgcn_s_sleep(1);
        if ((++sp & 255u) == 0u) { if (xb_ld(&bar[XB_TMO])) break; if (sp > XB_SPIN_CAP) { atomicAdd(&bar[XB_TMO], 1u); break; } }
    }
    nloc = mine > 0u ? mine : 1u; nx = cnt > 0u ? cnt : 1u;
}
DI void xcd_barrier(unsigned* bar, volatile LAS unsigned* st) {
    asm volatile("s_waitcnt vmcnt(0)" ::: "memory");
    __syncthreads();
    if (threadIdx.x == 0) {
        const unsigned x = xb_xcc_id();
        __builtin_amdgcn_s_waitcnt(0);
        unsigned nloc = st[0], nx = st[1];
        if (nloc == 0u) { xcd_barrier_complete(bar, x, nloc, nx); st[0] = nloc; st[1] = nx; }
        const unsigned old = xb_add(&bar[XB_XSUB(x)], 1u);
        const unsigned gen = old / nloc;
        if (old + 1u == (gen + 1u) * nloc) {
            __builtin_amdgcn_fence(__ATOMIC_RELEASE, "agent");
            asm volatile("s_waitcnt vmcnt(0)" ::: "memory");
            const unsigned og = xb_add(&bar[XB_TOP], 1u);
            const unsigned tg = og / nx;
            if (og + 1u == (tg + 1u) * nx) xb_add(&bar[XB_TOPGEN], 1u);
            else XB_SPIN(xb_ld(&bar[XB_TOPGEN]) == tg, bar);
            __builtin_amdgcn_fence(__ATOMIC_ACQUIRE, "agent");
            xb_add(&bar[XB_XGEN(x)], 1u);
            asm volatile("s_waitcnt vmcnt(0)" ::: "memory");
        } else {
            XB_SPIN(xb_ld(&bar[XB_XGEN(x)]) == gen, bar);
            __builtin_amdgcn_fence(__ATOMIC_ACQUIRE, "agent");
            asm volatile("s_waitcnt vmcnt(0)" ::: "memory");
        }
    }
    __syncthreads();
}

namespace pg8 {
constexpr int BM = 256, BK = 64, HALF = 128, HTB = HALF * BK * 2, STAGE_BYTES = 8 * HTB, NXCD = 8, WGM = 8;
DI int lds_byte(int r, int c) { const int st = (r >> 4) * 2 + (c >> 5), rr = r & 15, cc = c & 31, ob = rr * 64 + cc * 2; return st * 1024 + (ob ^ (((ob >> 9) & 1) << 5)); }
DI void stage_rc(int b, int& R, int& C) { const int st = b / 1024, sb = b % 1024, swz = sb ^ (((sb >> 9) & 1) << 5); R = (st >> 1) * 16 + swz / 64; C = (st & 1) * 32 + (swz % 64) / 2; }
DI int perm32(int rho) { const int n = rho >> 4, i = rho & 15; return 8 * (i >> 2) + 4 * n + (i & 3); }
struct Unit { int pm, pn; };
struct Gemm { const bf16_t* A; const bf16_t* Bt; int M, N, K, lda, ldb; };
struct StaticOrder {
    int nM, nN, nwg, G, c;
    DI void init(int M, int N, int G_, int c_) { nM = M / BM; nN = N / BM; nwg = nM * nN; G = G_; c = c_; }
    DI bool next(int i, Unit& u) const {
        const long L = (long)i * G + c; if (L >= nwg) return false;
        int wgid = (int)L; { const int q = nwg / NXCD, r = nwg % NXCD, xcd = wgid % NXCD, off = wgid / NXCD; wgid = (xcd < r ? xcd * (q + 1) : r * (q + 1) + (xcd - r) * q) + off; }
        const int nig = WGM * nN, gid = wgid / nig, fm = gid * WGM, gsz = (nM - fm) < WGM ? (nM - fm) : WGM;
        u.pm = fm + ((wgid % nig) % gsz); u.pn = (wgid % nig) / gsz; return true;
    }
};

template <class Epi>
DI void gemm_phase(const int TID, LAS unsigned char* lds, const Gemm g, const StaticOrder& S, const Epi& E) {
    const int tid = TID, wid = __builtin_amdgcn_readfirstlane(tid >> 6), lane = tid & 63, wr = wid >> 2, wc = wid & 3, fr = lane & 15, fq = lane >> 4;
    const int K = g.K, nt = K / BK;
    unsigned voffA[2], voffB[2];
#pragma unroll
    for (int i = 0; i < 2; ++i) { int R, C; stage_rc(tid * 16 + i * 8192, R, C); const int Rb = (R & ~31) + perm32(R & 31);
        voffA[i] = (unsigned)(R * g.lda + C) * 2u; voffB[i] = (unsigned)(Rb * g.ldb + C) * 2u; }
    const size_t kstep = (size_t)(BK * 2);
    const size_t hstepA = (size_t)HALF * g.lda * 2, hstepB = (size_t)HALF * g.ldb * 2;
    const size_t tstepA = 2 * hstepA, tstepB = 2 * hstepB;
    const unsigned ldsw = (unsigned)wid * 1024u;
    const int aoff = lds_byte(wr * 64 + fr, fq * 8), boff = lds_byte(wc * 32 + fr, fq * 8);
#define PG8_SA(b, h) (((b) * 2 + (h)) * HTB)
#define PG8_SB(b, h) ((4 + (b) * 2 + (h)) * HTB)
#define PG8_STAGE(bufoff, gbase, voff) do { _Pragma("unroll") for (int _i = 0; _i < 2; ++_i) \
        __builtin_amdgcn_global_load_lds((const unsigned*)((const char*)(gbase) + (voff)[_i]), (LAS unsigned*)(lds + (bufoff) + ldsw + _i * 8192), 16, 0, 0); } while (0)
#define PG8_LDA(dst, b, h) do { _Pragma("unroll") for (int m = 0; m < 4; ++m) _Pragma("unroll") for (int k = 0; k < 2; ++k) dst[m][k] = *(const LAS bf16x8*)(lds + PG8_SA(b, h) + aoff + m * 2048 + k * 1024); } while (0)
#define PG8_LDB(dst, b, h) do { _Pragma("unroll") for (int n = 0; n < 2; ++n) _Pragma("unroll") for (int k = 0; k < 2; ++k) dst[n][k] = *(const LAS bf16x8*)(lds + PG8_SB(b, h) + boff + n * 2048 + k * 1024); } while (0)
#define PG8_MMA(ai, bj, At, Bt) do { __builtin_amdgcn_s_setprio(1); _Pragma("unroll") for (int m = 0; m < 4; ++m) _Pragma("unroll") for (int n = 0; n < 2; ++n) _Pragma("unroll") for (int k = 0; k < 2; ++k) \
        acc[ai][bj][m][n] = __builtin_amdgcn_mfma_f32_16x16x32_bf16(Bt[n][k], At[m][k], acc[ai][bj][m][n], 0, 0, 0); __builtin_amdgcn_s_setprio(0); } while (0)
#define PG8_WAIT_V(n) asm volatile("s_waitcnt vmcnt(" #n ")" ::: "memory")
#define PG8_WAIT_L(n) asm volatile("s_waitcnt lgkmcnt(" #n ")" ::: "memory")
#define PG8_BAR __builtin_amdgcn_s_barrier()
#define PG8_SCHED __builtin_amdgcn_sched_barrier(0)
    Unit cur, nxt; int ui = 0;
    if (!S.next(0, cur)) return;
    f32x4 acc[2][2][4][2];
#pragma unroll
    for (int a = 0; a < 2; ++a)
#pragma unroll
        for (int b = 0; b < 2; ++b)
#pragma unroll
            for (int m = 0; m < 4; ++m)
#pragma unroll
                for (int n = 0; n < 2; ++n) acc[a][b][m][n] = (f32x4){0.f, 0.f, 0.f, 0.f};
    bf16x8 At[4][2], B0[2][2], B1[2][2];
    const char* cA = (const char*)g.A + (size_t)cur.pm * tstepA; const char* cB = (const char*)g.Bt + (size_t)cur.pn * tstepB;
    PG8_STAGE(PG8_SB(0, 0), cB, voffB); PG8_STAGE(PG8_SA(0, 0), cA, voffA); PG8_STAGE(PG8_SB(0, 1), cB + hstepB, voffB); PG8_STAGE(PG8_SA(0, 1), cA + hstepA, voffA);
    if (wr == 1) PG8_BAR;
    PG8_WAIT_V(4); PG8_BAR;
    PG8_STAGE(PG8_SB(1, 0), cB + kstep, voffB); PG8_STAGE(PG8_SA(1, 0), cA + kstep, voffA); PG8_STAGE(PG8_SB(1, 1), cB + hstepB + kstep, voffB);
    PG8_WAIT_V(6); PG8_BAR;
    for (;;) {
        const bool has_next = S.next(ui + 1, nxt);
        const char* nA = has_next ? (const char*)g.A + (size_t)nxt.pm * tstepA : cA; const char* nB = has_next ? (const char*)g.Bt + (size_t)nxt.pn * tstepB : cB;
        for (int t = 0; t < nt; t += 2) {
            const bool last = (t == nt - 2);
            const char* a1 = cA + (size_t)(t + 1) * kstep;
            const char* a2 = last ? nA : cA + (size_t)(t + 2) * kstep; const char* b2 = last ? nB : cB + (size_t)(t + 2) * kstep;
            const char* a3 = a2 + kstep; const char* b3 = b2 + kstep;
            PG8_LDB(B0, 0, 0); PG8_SCHED; PG8_LDA(At, 0, 0); PG8_STAGE(PG8_SA(1, 1), a1 + hstepA, voffA);
            PG8_WAIT_L(8); PG8_BAR; PG8_WAIT_L(0); PG8_MMA(0, 0, At, B0); PG8_BAR; PG8_SCHED;
            PG8_LDB(B1, 0, 1); PG8_STAGE(PG8_SB(0, 0), b2, voffB);
            PG8_BAR; PG8_WAIT_L(0); PG8_MMA(0, 1, At, B1); PG8_BAR;
            PG8_LDA(At, 0, 1); PG8_STAGE(PG8_SA(0, 0), a2, voffA);
            PG8_BAR; PG8_WAIT_L(0); PG8_MMA(1, 0, At, B0); PG8_BAR; PG8_SCHED;
            PG8_STAGE(PG8_SB(0, 1), b2 + hstepB, voffB);
            PG8_WAIT_V(6); PG8_BAR; PG8_MMA(1, 1, At, B1); PG8_BAR;
            PG8_LDB(B0, 1, 0); PG8_SCHED; PG8_LDA(At, 1, 0); PG8_STAGE(PG8_SA(0, 1), a2 + hstepA, voffA);
            PG8_WAIT_L(8); PG8_BAR; PG8_WAIT_L(0); PG8_MMA(0, 0, At, B0); PG8_BAR; PG8_SCHED;
            PG8_LDB(B1, 1, 1); PG8_STAGE(PG8_SB(1, 0), b3, voffB);
            PG8_BAR; PG8_WAIT_L(0); PG8_MMA(0, 1, At, B1); PG8_BAR;
            PG8_LDA(At, 1, 1); PG8_STAGE(PG8_SA(1, 0), a3, voffA);
            PG8_BAR; PG8_WAIT_L(0); PG8_MMA(1, 0, At, B0); PG8_BAR; PG8_SCHED;
            PG8_STAGE(PG8_SB(1, 1), b3 + hstepB, voffB);
            PG8_WAIT_V(6); PG8_BAR; PG8_MMA(1, 1, At, B1); PG8_BAR;
        }
        E(acc, cur, wr, wc, fr, fq);
        if (!has_next) break;
#pragma unroll
        for (int a = 0; a < 2; ++a)
#pragma unroll
            for (int b = 0; b < 2; ++b)
#pragma unroll
                for (int m = 0; m < 4; ++m)
#pragma unroll
                    for (int n = 0; n < 2; ++n) acc[a][b][m][n] = (f32x4){0.f, 0.f, 0.f, 0.f};
        cur = nxt; cA = nA; cB = nB; ++ui;
    }
    PG8_WAIT_V(0);
    if (wr == 0) PG8_BAR;
    PG8_BAR;
#undef PG8_SA
#undef PG8_SB
#undef PG8_STAGE
#undef PG8_LDA
#undef PG8_LDB
#undef PG8_MMA
#undef PG8_WAIT_V
#undef PG8_WAIT_L
#undef PG8_BAR
#undef PG8_SCHED
}

struct EpiStore {
    bf16_t* O; int ldc;
    DI void operator()(const f32x4 (&acc)[2][2][4][2], const Unit& u, int wr, int wc, int fr, int fq) const {
        const int row0 = u.pm * BM + wr * 64 + fr, col0 = u.pn * BM + wc * 32 + 8 * fq;
#pragma unroll
        for (int ai = 0; ai < 2; ++ai)
#pragma unroll
            for (int m = 0; m < 4; ++m) { bf16_t* rowp = O + (size_t)(row0 + ai * HALF + m * 16) * ldc + col0;
#pragma unroll
                for (int bj = 0; bj < 2; ++bj) { const f32x4 v0 = acc[ai][bj][m][0], v1 = acc[ai][bj][m][1];
                    u32x4 w; w.x = pk_bf16(v0[0], v0[1]); w.y = pk_bf16(v0[2], v0[3]); w.z = pk_bf16(v1[0], v1[1]); w.w = pk_bf16(v1[2], v1[3]);
                    *(u32x4*)(rowp + bj * HALF) = w; } }
    }
};
DI float silu_mul(float g, float u) { return g * __builtin_amdgcn_rcpf(1.0f + __expf(-g)) * u; }
struct EpiSwiGLU {
    bf16_t* O;
    DI void operator()(const f32x4 (&acc)[2][2][4][2], const Unit& u, int wr, int wc, int fr, int fq) const {
        const int row0 = u.pm * BM + wr * 64 + fr, col0 = u.pn * HALF + wc * 32 + 8 * fq;
#pragma unroll
        for (int ai = 0; ai < 2; ++ai)
#pragma unroll
            for (int m = 0; m < 4; ++m) { bf16_t* rowp = O + (size_t)(row0 + ai * HALF + m * 16) * DFF + col0;
                const f32x4 g0 = acc[ai][0][m][0], g1 = acc[ai][0][m][1], u0 = acc[ai][1][m][0], u1 = acc[ai][1][m][1];
                u32x4 w; w.x = pk_bf16(silu_mul(g0[0], u0[0]), silu_mul(g0[1], u0[1])); w.y = pk_bf16(silu_mul(g0[2], u0[2]), silu_mul(g0[3], u0[3]));
                w.z = pk_bf16(silu_mul(g1[0], u1[0]), silu_mul(g1[1], u1[1])); w.w = pk_bf16(silu_mul(g1[2], u1[2]), silu_mul(g1[3], u1[3]));
                *(u32x4*)rowp = w; }
    }
};
}

struct TJ { const float* s0; const float* s1; bf16_t* dst; int ld, Ks, Nd, Kd, mode, colbase, nvalid, nbatch; size_t sstride, dstride; };

DI TJ make_tj(KP p, int jdx) {
    TJ j; j.s1 = nullptr; j.mode = 0; j.colbase = 0; j.nbatch = 1; j.sstride = 0; j.dstride = 0;
    bf16_t* W = (bf16_t*)(p->ws + WS_W);
    if (jdx < 16) {
        const int lf = jdx >> 1;
        if ((jdx & 1) == 0) { j.s0 = p->in[9] + (size_t)lf * DM * DFF; j.s1 = p->in[10] + (size_t)lf * DM * DFF; j.dst = W + lf * W_FFN + W_GU; j.ld = DFF; j.Ks = DM; j.Nd = 2 * DFF; j.Kd = DM; j.mode = 1; j.nvalid = 2 * DFF; }
        else { j.s0 = p->in[11] + (size_t)lf * DM * DFF; j.dst = W + lf * W_FFN + W_D; j.ld = DM; j.Ks = DFF; j.Nd = DM; j.Kd = DFF; j.nvalid = DM; }
    } else if (jdx < 28) {
        const int i = (jdx - 16) / 6, k = (jdx - 16) % 6; bf16_t* B = W + W_EVB + i * W_EV;
        if (k == 0) { j.s0 = p->in[12] + (size_t)i * DM * 1952; j.dst = B + WE_IN; j.ld = 1952; j.Ks = DM; j.Nd = 2048; j.Kd = DM; j.nvalid = 1952; }
        else if (k == 1) { j.s0 = p->in[12] + (size_t)i * DM * 1952; j.dst = B + WE_INV; j.ld = 1952; j.Ks = DM; j.Nd = 512; j.Kd = DM; j.colbase = 1440; j.nvalid = 512; }
        else if (k == 2) { j.s0 = p->in[14] + (size_t)i * 256 * 768; j.dst = B + WE_UQ; j.ld = 768; j.Ks = 256; j.Nd = 768; j.Kd = 256; j.nvalid = 768; }
        else if (k == 3) { j.s0 = p->in[16] + (size_t)i * 128 * 1024; j.dst = B + WE_UK; j.ld = 1024; j.Ks = 128; j.Nd = 512; j.Kd = 256; j.mode = 2; j.colbase = 0; j.nvalid = 512; }
        else if (k == 4) { j.s0 = p->in[16] + (size_t)i * 128 * 1024; j.dst = B + WE_UV; j.ld = 1024; j.Ks = 128; j.Nd = 512; j.Kd = 256; j.mode = 2; j.colbase = 64; j.nvalid = 512; }
        else { j.s0 = p->in[18] + (size_t)i * DM * DM; j.dst = B + WE_OUT; j.ld = DM; j.Ks = DM; j.Nd = DM; j.Kd = DM; j.nvalid = DM; }
    } else if (jdx < 34) {
        const int i = (jdx - 28) / 3, k = (jdx - 28) % 3; bf16_t* B = W + W_ODB + i * W_OD;
        if (k == 0) { j.s0 = p->in[19] + (size_t)i * DM * 1280; j.dst = B + WO_IN; j.ld = 1280; j.Ks = DM; j.Nd = 1280; j.Kd = DM; j.nvalid = 1280; }
        else if (k == 1) { j.s0 = p->in[19] + (size_t)i * DM * 1280; j.dst = B + WO_INV; j.ld = 1280; j.Ks = DM; j.Nd = 256; j.Kd = DM; j.colbase = 1152; j.nvalid = 128; }
        else { j.s0 = p->in[21] + (size_t)i * DM * DM; j.dst = B + WO_OUT; j.ld = DM; j.Ks = DM; j.Nd = DM; j.Kd = DM; j.nvalid = DM; }
    } else if (jdx == 34) {
        j.s0 = p->in[5]; j.dst = (bf16_t*)(p->ws + WS_VTBC); j.ld = 512; j.Ks = 512; j.Nd = 512; j.Kd = 512; j.nvalid = 512; j.nbatch = 64; j.sstride = 512 * 512; j.dstride = 512 * 512;
    } else {
        j.s0 = p->in[7]; j.dst = (bf16_t*)(p->ws + WS_VTCC); j.ld = 128; j.Ks = 128; j.Nd = 128; j.Kd = 128; j.nvalid = 128; j.nbatch = 64; j.sstride = 128 * 128; j.dstride = 128 * 128;
    }
    return j;
}

DI void tj_run(const int TID, const int BID, const TJ& j, int& rot, LAS float* tile) {
    const int G = gridDim.x, tid = TID;
    const int tk = j.Kd / 64, per = (j.Nd / 64) * tk, nt = per * j.nbatch;
    int first = BID - rot; if (first < 0) first += G;
    const int nl = tid & 63, kl = tid >> 6;
    float v[8];
#define TJ_LOAD(t_) do { const int batch = (t_) / per, r = (t_) % per, n0 = (r / tk) * 64, k0 = (r % tk) * 64, n = n0 + nl; \
        const float* src = j.s0; int col; \
        if (j.mode == 0) col = n < j.nvalid ? j.colbase + n : -1; \
        else if (j.mode == 1) { const int pn = n >> 8, bj = (n >> 7) & 1, jj = n & 127; if (bj) src = j.s1; col = pn * 128 + jj; } \
        else col = (n >> 6) * 128 + (n & 63) + j.colbase; \
        src += (size_t)batch * j.sstride; \
        _Pragma("unroll") for (int i = 0; i < 8; ++i) { const int k = k0 + kl + 8 * i; v[i] = 0.f; if (col >= 0 && k < j.Ks) v[i] = src[(size_t)k * j.ld + col]; } } while (0)
    if (first < nt) TJ_LOAD(first);
    for (int t = first; t < nt; t += G) {
        const int batch = t / per, r = t % per, n0 = (r / tk) * 64, k0 = (r % tk) * 64;
#pragma unroll
        for (int i = 0; i < 8; ++i) tile[(kl + 8 * i) * 65 + nl] = v[i];
        __syncthreads();
        if (t + G < nt) TJ_LOAD(t + G);
        {   const int kp = (tid & 31) * 2, nl2 = tid >> 5; bf16_t* d = j.dst + (size_t)batch * j.dstride;
#pragma unroll
            for (int i = 0; i < 4; ++i) { const int n = nl2 + 16 * i; const float v0 = tile[kp * 65 + n], v1 = tile[(kp + 1) * 65 + n];
                *(unsigned*)(d + (size_t)(n0 + n) * j.Kd + k0 + kp) = pk_bf16(v0, v1); }
        }
        __syncthreads();
    }
#undef TJ_LOAD
    rot = (rot + nt) % G;
}

DI f32x2 rope_entry(int pos, int j, double c) {
    double inv = 1.0; for (int i = 0; i < j; ++i) inv *= c;
    const double a = (double)pos * inv;
    const double k = rint(a * 0.15915494309189535);
    const double r = fma(-k, 6.283185307179586, a) - k * 2.4492935982947064e-16;
    const double r2 = r * r;
    double s = 1.0 / 121645100408832000.0, cc = 1.0 / 2432902008176640000.0;
    s = s * r2 * -1.0 + 1.0 / 355687428096000.0;  cc = cc * r2 * -1.0 + 1.0 / 6402373705728000.0;
    s = s * r2 * -1.0 + 1.0 / 1307674368000.0;    cc = cc * r2 * -1.0 + 1.0 / 20922789888000.0;
    s = s * r2 * -1.0 + 1.0 / 6227020800.0;       cc = cc * r2 * -1.0 + 1.0 / 87178291200.0;
    s = s * r2 * -1.0 + 1.0 / 39916800.0;         cc = cc * r2 * -1.0 + 1.0 / 479001600.0;
    s = s * r2 * -1.0 + 1.0 / 362880.0;           cc = cc * r2 * -1.0 + 1.0 / 3628800.0;
    s = s * r2 * -1.0 + 1.0 / 5040.0;             cc = cc * r2 * -1.0 + 1.0 / 40320.0;
    s = s * r2 * -1.0 + 1.0 / 120.0;              cc = cc * r2 * -1.0 + 1.0 / 720.0;
    s = s * r2 * -1.0 + 1.0 / 6.0;                cc = cc * r2 * -1.0 + 1.0 / 24.0;
    s = s * r2 * -1.0 + 1.0;                      cc = cc * r2 * -1.0 + 0.5;
    s = s * r;                                    cc = cc * r2 * -1.0 + 1.0;
    f32x2 o; o.x = (float)cc; o.y = (float)s; return o;
}

DI void norm_phase(const int TID, const int BID, KP p, const bf16_t* R, const bf16_t* Rs, int nsp, const float* gpost, float cmul, const float* gpre, bool first) {
    const int lane = TID & 63, gw = BID * 8 + (TID >> 6), nw = gridDim.x * 8;
    bf16_t* XB = (bf16_t*)p->out + (size_t)T * DM;
    float* YT = (float*)(p->ws + WS_HH);
    const bool lastp = !first && gpre == nullptr;
    bf16_t* H = (bf16_t*)(p->ws + WS_HO);
    for (int row0 = gw; row0 < T; row0 += 2 * nw) {
        const bool has2 = row0 + nw < T;
        int rows[2]; rows[0] = row0; rows[1] = has2 ? row0 + nw : row0;
        f32x4 xv[2][4], rv[2][4];
#pragma unroll
        for (int u = 0; u < 2; ++u) { const int row = rows[u];
            if (first) { const float* src = row < TP ? p->in[0] + (size_t)row * DM : p->in[1] + (size_t)(row - TP) * DM;
#pragma unroll
                for (int i = 0; i < 4; ++i) xv[u][i] = *(const f32x4*)(src + 4 * lane + 256 * i); }
            else {
#pragma unroll
                for (int i = 0; i < 4; ++i) { const u32x2 w = *(const u32x2*)(XB + (size_t)row * DM + 4 * lane + 256 * i); xv[u][i] = (f32x4){bf_lo(w.x), bf_hi(w.x), bf_lo(w.y), bf_hi(w.y)}; } }
            if (!first) {
                if (row < TP) {
#pragma unroll
                    for (int i = 0; i < 4; ++i) { const u32x2 w = *(const u32x2*)(R + (size_t)row * DM + 4 * lane + 256 * i); rv[u][i] = (f32x4){bf_lo(w.x), bf_hi(w.x), bf_lo(w.y), bf_hi(w.y)}; }
                } else {
#pragma unroll
                    for (int i = 0; i < 4; ++i) rv[u][i] = (f32x4){0.f, 0.f, 0.f, 0.f};
                    for (int sp = 0; sp < nsp; ++sp) {
#pragma unroll
                        for (int i = 0; i < 4; ++i) { const u32x2 w = *(const u32x2*)(Rs + ((size_t)sp * TS + (row - TP)) * DM + 4 * lane + 256 * i);
                            rv[u][i] += (f32x4){bf_lo(w.x), bf_hi(w.x), bf_lo(w.y), bf_hi(w.y)}; } }
                }
            }
        }
#pragma unroll
        for (int u = 0; u < 2; ++u) { const int row = rows[u]; const bool act = u == 0 || has2;
            if (!first) {
                float ss = 0.f;
#pragma unroll
                for (int i = 0; i < 4; ++i) ss += rv[u][i][0] * rv[u][i][0] + rv[u][i][1] * rv[u][i][1] + rv[u][i][2] * rv[u][i][2] + rv[u][i][3] * rv[u][i][3];
                ss = wave_sum(ss);
                const float rs = rsqrtf(ss * (1.0f / DM) + EPS) * cmul;
#pragma unroll
                for (int i = 0; i < 4; ++i) { const f32x4 g = *(const f32x4*)(gpost + 4 * lane + 256 * i); xv[u][i] += rv[u][i] * g * rs; }
            }
            if (act) {
                if (lastp) { float* yd = row < T / 2 ? p->out : YT;
#pragma unroll
                    for (int i = 0; i < 4; ++i) *(f32x4*)(yd + (size_t)row * DM + 4 * lane + 256 * i) = xv[u][i]; }
                else {
#pragma unroll
                    for (int i = 0; i < 4; ++i) { u32x2 w; w.x = pk_bf16(xv[u][i][0], xv[u][i][1]); w.y = pk_bf16(xv[u][i][2], xv[u][i][3]); *(u32x2*)(XB + (size_t)row * DM + 4 * lane + 256 * i) = w; } } }
            if (gpre) {
                float ss = 0.f;
#pragma unroll
                for (int i = 0; i < 4; ++i) ss += xv[u][i][0] * xv[u][i][0] + xv[u][i][1] * xv[u][i][1] + xv[u][i][2] * xv[u][i][2] + xv[u][i][3] * xv[u][i][3];
                ss = wave_sum(ss);
                const float rs = rsqrtf(ss * (1.0f / DM) + EPS);
                if (act) {
#pragma unroll
                    for (int i = 0; i < 4; ++i) { const f32x4 g = *(const f32x4*)(gpre + 4 * lane + 256 * i); const f32x4 o = xv[u][i] * g * rs;
                        u32x2 w; w.x = pk_bf16(o[0], o[1]); w.y = pk_bf16(o[2], o[3]); *(u32x2*)(H + (size_t)row * DM + 4 * lane + 256 * i) = w; } }
            }
        }
    }
}

DI void post_even(const int TID, const int BID, KP p, int i) {
    const int lane = TID & 63, gw = BID * 8 + (TID >> 6), nw = gridDim.x * 8;
    bf16_t* P = (bf16_t*)(p->ws + WS_P);
    const float* qn = p->in[13] + i * 256; const float* kvn = p->in[15] + i * 128;
    const f32x2* ropeA = (const f32x2*)(p->ws + WS_ROPEA);
    const f32x4 gq = *(const f32x4*)(qn + 4 * lane); const f32x2 gk = *(const f32x2*)(kvn + 2 * lane);
    for (int row = gw; row < T; row += nw) {
        const bool smp = row >= TP; const int rs_ = row - TP;
        const int b = smp ? (rs_ >> 5) : (row >> 11), t = smp ? (rs_ & 31) : (row & 2047), pos = smp ? 1024 + t : t, Tl = smp ? 32 : 2048;
        bf16_t* Pr = P + (size_t)row * 2048;
        const bool wout = smp || t >= 1536;
        const u32x2 wq = *(const u32x2*)(Pr + 4 * lane);
        const unsigned wk = *(const unsigned*)(Pr + 256 + 2 * lane);
        const float vpe = bf2f(Pr[384 + (lane & 31)]);
        const f32x2 cs = ropeA[pos * 16 + (lane & 15)];
        u32x4 kw = {0u, 0u, 0u, 0u}, vw = {0u, 0u, 0u, 0u};
        if (wout) { kw = *(const u32x4*)(Pr + 928 + 8 * lane); vw = *(const u32x4*)(Pr + 1440 + 8 * lane); }
        f32x4 v = {bf_lo(wq.x), bf_hi(wq.x), bf_lo(wq.y), bf_hi(wq.y)};
        float v0 = bf_lo(wk), v1 = bf_hi(wk);
        float ssq = v[0] * v[0] + v[1] * v[1] + v[2] * v[2] + v[3] * v[3], ssk = v0 * v0 + v1 * v1;
#pragma unroll
        for (int o = 32; o; o >>= 1) { ssq += __shfl_xor(ssq, o); ssk += __shfl_xor(ssk, o); }
        const float rq = rsqrtf(ssq * (1.0f / 256) + EPS), rk = rsqrtf(ssk * (1.0f / 128) + EPS);
        v = v * gq * rq; v0 = v0 * gk.x * rk; v1 = v1 * gk.y * rk;
        const float pr = __shfl_xor(vpe, 16);
        const float ope = (lane & 16) ? vpe * cs.x + pr * cs.y : vpe * cs.x - pr * cs.y;
        { u32x2 o; o.x = pk_bf16(v[0], v[1]); o.y = pk_bf16(v[2], v[3]); *(u32x2*)(Pr + 4 * lane) = o; }
        *(unsigned*)(Pr + 256 + 2 * lane) = pk_bf16(v0, v1);
        { float* o = p->out + (smp ? O_CKVS : O_CKVP) + ((size_t)(i * 32 + b) * Tl + t) * 128 + 2 * lane; *(f32x2*)o = (f32x2){v0, v1}; }
        if (lane < 32) { Pr[384 + lane] = f2bf(ope); p->out[(smp ? O_KPES : O_KPEP) + ((size_t)(i * 32 + b) * Tl + t) * 32 + lane] = ope; }
        if (wout) {
            const int tr = smp ? t : t - 1536, Tb = smp ? 32 : 512;
            float* ok = p->out + (smp ? O_BKS : O_BKP) + ((size_t)(i * 32 + b) * Tb + tr) * 512 + 8 * lane;
            float* ov = p->out + (smp ? O_BVS : O_BVP) + ((size_t)(i * 32 + b) * Tb + tr) * 512 + 8 * lane;
            *(f32x4*)ok = (f32x4){bf_lo(kw.x), bf_hi(kw.x), bf_lo(kw.y), bf_hi(kw.y)}; *(f32x4*)(ok + 4) = (f32x4){bf_lo(kw.z), bf_hi(kw.z), bf_lo(kw.w), bf_hi(kw.w)};
            *(f32x4*)ov = (f32x4){bf_lo(vw.x), bf_hi(vw.x), bf_lo(vw.y), bf_hi(vw.y)}; *(f32x4*)(ov + 4) = (f32x4){bf_lo(vw.z), bf_hi(vw.z), bf_lo(vw.w), bf_hi(vw.w)}; }
    }
}

DI void post_odd(const int TID, const int BID, KP p, int i) {
    const int lane = TID & 63, gw = BID * 8 + (TID >> 6), nw = gridDim.x * 8;
    bf16_t* P = (bf16_t*)(p->ws + WS_P);
    const f32x2* ropeC = (const f32x2*)(p->ws + WS_ROPEC);
    for (int row = gw; row < T; row += nw) {
        const bool smp = row >= TP; const int rs_ = row - TP;
        const int b = smp ? (rs_ >> 5) : (row >> 11), t = smp ? (rs_ & 31) : (row & 2047), pos = smp ? 1024 + t : t;
        const bool wout = smp || t >= 1920; const int tr = smp ? t : t - 1920, Tb = smp ? 32 : 128;
        bf16_t* Pr = P + (size_t)row * 1280;
        float* ok = p->out + (smp ? O_SKS : O_SKP) + ((size_t)(i * 32 + b) * Tb + tr) * 128;
        float* ov = p->out + (smp ? O_SVS : O_SVP) + ((size_t)(i * 32 + b) * Tb + tr) * 128;
        const f32x2 cs = ropeC[pos * 8 + (lane & 7)];
        float vv[5]; unsigned vw = 0u, kw = 0u;
#pragma unroll
        for (int it = 0; it < 5; ++it) { const int e = lane + 64 * it; const int col = (e >> 4) * 64 + (e & 15); vv[it] = e < 288 ? bf2f(Pr[col]) : 0.f; }
        const int idx = 2 * lane, hd = idx / 48, jn = 16 + idx % 48;
        if (wout) { vw = *(const unsigned*)(Pr + 1152 + 2 * lane); if (lane < 48) kw = *(const unsigned*)(Pr + 1024 + hd * 64 + jn); }
#pragma unroll
        for (int it = 0; it < 5; ++it) {
            const int e = lane + 64 * it; const bool act = e < 288; const int head = e >> 4, jj = e & 15, col = head * 64 + jj;
            const float v = vv[it]; const float pr = __shfl_xor(v, 8);
            const float o = (jj & 8) ? v * cs.x + pr * cs.y : v * cs.x - pr * cs.y;
            if (act) { Pr[col] = f2bf(o); if (wout && head >= 16) ok[(head - 16) * 64 + jj] = o; }
        }
        if (wout) {
            *(f32x2*)(ov + 2 * lane) = (f32x2){bf_lo(vw), bf_hi(vw)};
            if (lane < 48) *(f32x2*)(ok + hd * 64 + jn) = (f32x2){bf_lo(kw), bf_hi(kw)};
        }
    }
}

struct ASeg { const void* k1; const bf16_t* k2; const bf16_t* vt; int k1ld, k2ld, k1f32; size_t vtld; int nkeys, kpos0; };

template <int NQT, int KS, bool QL>
DI void attn_item(const bf16_t* q0, const bf16_t* q1, int qld, int nseg, const ASeg& sa, const ASeg& sb, float scale,
                  const LAS float* tbl, bool has_bias, int qpos0, bool has_sink, float sink0, float sink1, bf16_t* o0, bf16_t* o1, int old, int lane,
                  LAS bf16x8* qbuf, const f32x2* ropeA) {
    const int lr = lane & 31, lh = lane >> 5;
    bf16x8 qf[QL ? 1 : NQT][QL ? 1 : KS];
#pragma unroll
    for (int qt = 0; qt < NQT; ++qt) {
        bf16x8 tq[KS];
#pragma unroll
        for (int ks = 0; ks < KS; ++ks) tq[ks] = *(const bf16x8*)((qt ? q1 : q0) + (size_t)lr * qld + 16 * ks + 8 * lh);
        if (KS == 6) {
            const f32x2* cs = ropeA + (qpos0 + 32 * qt + lr) * 16 + 8 * lh;
            const u32x4 a = __builtin_bit_cast(u32x4, tq[4]), b = __builtin_bit_cast(u32x4, tq[KS - 1]); u32x4 ra, rb;
#pragma unroll
            for (int w = 0; w < 4; ++w) { const f32x2 c0 = cs[2 * w], c1 = cs[2 * w + 1];
                const float x10 = bf_lo(a[w]), x11 = bf_hi(a[w]), x20 = bf_lo(b[w]), x21 = bf_hi(b[w]);
                ra[w] = pk_bf16(x10 * c0.x - x20 * c0.y, x11 * c1.x - x21 * c1.y); rb[w] = pk_bf16(x20 * c0.x + x10 * c0.y, x21 * c1.x + x11 * c1.y); }
            tq[4] = __builtin_bit_cast(bf16x8, ra); tq[KS - 1] = __builtin_bit_cast(bf16x8, rb);
        }
#pragma unroll
        for (int ks = 0; ks < KS; ++ks) { if (QL) qbuf[(qt * KS + ks) * 64 + lane] = tq[ks]; else qf[QL ? 0 : qt][QL ? 0 : ks] = tq[ks]; }
    }
    f32x16 O[2][NQT]; float mx[NQT], ls[NQT];
#pragma unroll
    for (int qt = 0; qt < NQT; ++qt) { mx[qt] = -1e30f; ls[qt] = 0.f;
#pragma unroll
        for (int dt = 0; dt < 2; ++dt)
#pragma unroll
            for (int r = 0; r < 16; ++r) O[dt][qt][r] = 0.f; }
    const float sl = scale * LOG2E;
    for (int sg = 0; sg < nseg; ++sg) {
        const void* k1 = sg ? sb.k1 : sa.k1; const bf16_t* k2 = sg ? sb.k2 : sa.k2; const bf16_t* vt = sg ? sb.vt : sa.vt;
        const int k1ld = sg ? sb.k1ld : sa.k1ld, k2ld = sg ? sb.k2ld : sa.k2ld, k1f32 = sg ? sb.k1f32 : sa.k1f32;
        const size_t vtld = sg ? sb.vtld : sa.vtld; const int nkeys = sg ? sb.nkeys : sa.nkeys, kpos0 = sg ? sb.kpos0 : sa.kpos0;
        for (int kb = 0; kb < nkeys; kb += 32) {
            int qo = lane; asm volatile("" : "+v"(qo));
            bf16x8 kf[KS];
#pragma unroll
            for (int ks = 0; ks < KS; ++ks) {
                if (ks < 4) {
                    if (k1f32) { const float* kp = (const float*)k1 + (size_t)(kb + lr) * k1ld + 16 * ks + 8 * lh; const f32x4 a = *(const f32x4*)kp, b = *(const f32x4*)(kp + 4);
                        u32x4 w; w.x = pk_bf16(a[0], a[1]); w.y = pk_bf16(a[2], a[3]); w.z = pk_bf16(b[0], b[1]); w.w = pk_bf16(b[2], b[3]); kf[ks] = __builtin_bit_cast(bf16x8, w); }
                    else kf[ks] = *(const bf16x8*)((const bf16_t*)k1 + (size_t)(kb + lr) * k1ld + 16 * ks + 8 * lh);
                } else kf[ks] = *(const bf16x8*)(k2 + (size_t)(kb + lr) * k2ld + 16 * (ks - 4) + 8 * lh);
            }
            bf16x8 vf[2][2];
#pragma unroll
            for (int dt = 0; dt < 2; ++dt)
#pragma unroll
                for (int st = 0; st < 2; ++st) { const bf16_t* vp = vt + (size_t)(32 * dt + lr) * vtld + kb + 16 * st + 4 * lh;
                    const u32x2 a = *(const u32x2*)vp, b = *(const u32x2*)(vp + 8); u32x4 w = {a.x, a.y, b.x, b.y}; vf[dt][st] = __builtin_bit_cast(bf16x8, w); }
            bf16x8 pf[NQT][2];
#pragma unroll
            for (int qt = 0; qt < NQT; ++qt) {
                f32x16 s;
#pragma unroll
                for (int r = 0; r < 16; ++r) s[r] = 0.f;
#pragma unroll
                for (int ks = 0; ks < KS; ++ks) { const bf16x8 qv = QL ? qbuf[(qt * KS + ks) * 64 + qo] : qf[QL ? 0 : qt][QL ? 0 : ks]; s = __builtin_amdgcn_mfma_f32_32x32x16_bf16(kf[ks], qv, s, 0, 0, 0); }
                if (has_bias) {
                    const int kp0 = kpos0 + kb;
                    if (qpos0 - (kp0 + 31) >= 128) { const float c = tbl[256] * LOG2E;
#pragma unroll
                        for (int r = 0; r < 16; ++r) s[r] = s[r] * sl + c; }
                    else { const int qp = qpos0 + 32 * qt + lr;
#pragma unroll
                        for (int r = 0; r < 16; ++r) { const int kp = kp0 + (r & 3) + 8 * (r >> 2) + 4 * lh; int idx = qp - kp + 128; idx = idx < 0 ? 0 : (idx > 256 ? 256 : idx);
                            s[r] = s[r] * sl + tbl[idx] * LOG2E; } }
                } else {
#pragma unroll
                    for (int r = 0; r < 16; ++r) s[r] *= sl;
                }
                float m = s[0];
#pragma unroll
                for (int r = 1; r < 16; ++r) m = fmaxf(m, s[r]);
                m = fmaxf(m, __shfl_xor(m, 32));
                const float mn = fmaxf(mx[qt], m), alpha = __builtin_amdgcn_exp2f(mx[qt] - mn); mx[qt] = mn;
                float psum = 0.f;
#pragma unroll
                for (int r = 0; r < 16; ++r) { s[r] = __builtin_amdgcn_exp2f(s[r] - mn); psum += s[r]; }
                ls[qt] = ls[qt] * alpha + psum;
#pragma unroll
                for (int dt = 0; dt < 2; ++dt)
#pragma unroll
                    for (int r = 0; r < 16; ++r) O[dt][qt][r] *= alpha;
#pragma unroll
                for (int st = 0; st < 2; ++st) { u32x4 w; w.x = pk_bf16(s[8 * st], s[8 * st + 1]); w.y = pk_bf16(s[8 * st + 2], s[8 * st + 3]);
                    w.z = pk_bf16(s[8 * st + 4], s[8 * st + 5]); w.w = pk_bf16(s[8 * st + 6], s[8 * st + 7]); pf[qt][st] = __builtin_bit_cast(bf16x8, w); }
            }
#pragma unroll
            for (int qt = 0; qt < NQT; ++qt)
#pragma unroll
                for (int dt = 0; dt < 2; ++dt)
#pragma unroll
                    for (int st = 0; st < 2; ++st) O[dt][qt] = __builtin_amdgcn_mfma_f32_32x32x16_bf16(vf[dt][st], pf[qt][st], O[dt][qt], 0, 0, 0);
        }
    }
#pragma unroll
    for (int qt = 0; qt < NQT; ++qt) {
        float l = ls[qt] + __shfl_xor(ls[qt], 32);
        if (has_sink) l += __builtin_amdgcn_exp2f((qt ? sink1 : sink0) * LOG2E - mx[qt]);
        const float inv = 1.0f / l;
        bf16_t* op = (qt ? o1 : o0) + (size_t)lr * old + 4 * lh;
#pragma unroll
        for (int dt = 0; dt < 2; ++dt)
#pragma unroll
            for (int g = 0; g < 4; ++g) { u32x2 w; w.x = pk_bf16(O[dt][qt][4 * g] * inv, O[dt][qt][4 * g + 1] * inv); w.y = pk_bf16(O[dt][qt][4 * g + 2] * inv, O[dt][qt][4 * g + 3] * inv);
                *(u32x2*)(op + 32 * dt + 8 * g) = w; }
    }
}

DI int next_item(unsigned* ctr, int lane) { int id = 0; if (lane == 0) id = (int)atomicAdd(ctr, 1u); return __builtin_amdgcn_readfirstlane(id); }

DI void attn_even(const int TID, KP p, int i, LAS unsigned char* lds) {
    const int lane = TID & 63, wid = TID >> 6;
    const bf16_t* P = (const bf16_t*)(p->ws + WS_P); const bf16_t* QA = (const bf16_t*)(p->ws + WS_QA); const bf16_t* KN = (const bf16_t*)(p->ws + WS_KN);
    const bf16_t* VTA = (const bf16_t*)(p->ws + WS_VTA); const bf16_t* VTB = (const bf16_t*)(p->ws + WS_VTB);
    const bf16_t* KNC = (const bf16_t*)(p->ws + WS_KNC); const bf16_t* VTAC = (const bf16_t*)(p->ws + WS_VTAC);
    const bf16_t* KPEC = (const bf16_t*)(p->ws + WS_KPEC); const bf16_t* VTBC = (const bf16_t*)(p->ws + WS_VTBC);
    bf16_t* HO = (bf16_t*)(p->ws + WS_HO);
    LAS float* tbl = (LAS float*)(lds + wid * 1280);
    LAS bf16x8* qbuf = (LAS bf16x8*)(lds + 16384 + wid * 12288); const f32x2* ropeA = (const f32x2*)(p->ws + WS_ROPEA);
    volatile LAS int* gword = (volatile LAS int*)(lds + 131072 + 64);
    const float ascale = 0.10206207261596575f;
    ASeg sa, sb; sa.k2 = nullptr; sa.k2ld = 0; sa.k1f32 = 0; sa.kpos0 = 0; sb = sa; sb.k1 = nullptr; sb.vt = nullptr; sb.k1ld = 0; sb.vtld = 0; sb.nkeys = 0;
    const int x0 = (int)(xb_xcc_id() & 7u);
    for (int xi = 0; xi < 8; ++xi) { const int x = (x0 + xi) & 7; unsigned* ctr = (unsigned*)(p->ws + WS_CTL) + ((2 * i) * 8 + x) * 16;
    for (;;) {
        __syncthreads();
        if (TID == 0) *gword = (int)atomicAdd(ctr, 1u);
        __syncthreads();
        const int g = *gword;
        if (g >= 200) break;
        const int id = g < 64 ? 0 : (g < 68 ? 1024 + (g - 64) * 8 + wid : (g < 72 ? 1056 + (g - 68) * 8 + wid : 1088 + (g - 72) * 8 + wid));
        if (g < 64) {
          for (int part = 0; part < 2; ++part) {
            const int pr = g >> 1, gg = g & 1, c = part == 0 ? (gg ? 23 : 31) - wid : (gg ? 8 : 0) + wid, b = x + 8 * (pr >> 3), h = pr & 7; const size_t r0 = (size_t)b * 2048;
            sa.k1 = KN + r0 * 512 + h * 64; sa.k1ld = 512; sa.k1f32 = 0; sa.k2 = P + r0 * 2048 + 384; sa.k2ld = 2048; sa.vt = VTA + (size_t)(h * 64) * T + r0; sa.vtld = T; sa.nkeys = (c + 1) * 64; sa.kpos0 = 0;
            const bf16_t* q = QA + (r0 + c * 64) * 768 + h * 96; bf16_t* o = HO + (r0 + c * 64) * 1024 + h * 64;
            attn_item<2, 6, true>(q, q + 32 * 768, 768, 1, sa, sb, ascale, tbl, false, c * 64, false, 0.f, 0.f, o, o + 32 * 1024, 1024, lane, qbuf, ropeA);
          }
        } else if (id < 1056) {
            const int e = id - 1024, b = x + 8 * (e >> 3), h = e & 7; const size_t rn = (size_t)TP + b * 32;
            sa.k1 = KNC + (size_t)(b * 1024) * 512 + h * 64; sa.k1ld = 512; sa.k1f32 = 0; sa.k2 = KPEC + ((size_t)i * 32768 + b * 1024) * 32; sa.k2ld = 32;
            sa.vt = VTAC + (size_t)(h * 64) * 32768 + b * 1024; sa.vtld = 32768; sa.nkeys = 1024; sa.kpos0 = 0;
            sb.k1 = KN + rn * 512 + h * 64; sb.k1ld = 512; sb.k1f32 = 0; sb.k2 = P + rn * 2048 + 384; sb.k2ld = 2048; sb.vt = VTA + (size_t)(h * 64) * T + rn; sb.vtld = T; sb.nkeys = 32; sb.kpos0 = 0;
            const bf16_t* q = QA + rn * 768 + h * 96; bf16_t* o = HO + rn * 1024 + h * 64;
            attn_item<1, 6, false>(q, q, 768, 2, sa, sb, ascale, tbl, false, 1024, false, 0.f, 0.f, o, o, 1024, lane, qbuf, ropeA);
        } else {
            const bool smp = id < 1088; int b, h, c = 0;
            if (smp) { const int e = id - 1056; b = x + 8 * (e >> 3); h = e & 7; } else { const int e = id - 1088, r = e & 255, pr = r >> 3; c = 8 * (3 - (e >> 8)) + 7 - (r & 7); b = x + 8 * (pr >> 3); h = pr & 7; }
            const float* rel = p->in[17] + (size_t)(i * 8 + h) * 257;
            for (int j = lane; j < 257; j += 64) tbl[j] = rel[j];
            if (smp) {
                const size_t rn = (size_t)TP + b * 32;
                sa.k1 = p->in[4] + ((size_t)(i * 32 + b) * 512) * 512 + h * 64; sa.k1ld = 512; sa.k1f32 = 1; sa.k2 = nullptr; sa.k2ld = 0;
                sa.vt = VTBC + ((size_t)(i * 32 + b) * 512 + h * 64) * 512; sa.vtld = 512; sa.nkeys = 512; sa.kpos0 = 512;
                sb.k1 = P + rn * 2048 + 928 + h * 64; sb.k1ld = 2048; sb.k1f32 = 0; sb.k2 = nullptr; sb.k2ld = 0; sb.vt = VTB + (size_t)(h * 64) * T + rn; sb.vtld = T; sb.nkeys = 32; sb.kpos0 = 1024;
                const bf16_t* q = P + rn * 2048 + 416 + h * 64; bf16_t* o = HO + rn * 1024 + 512 + h * 64;
                attn_item<1, 4, false>(q, q, 2048, 2, sa, sb, 0.125f, tbl, true, 1024, false, 0.f, 0.f, o, o, 1024, lane, qbuf, ropeA);
            } else {
                const size_t r0 = (size_t)b * 2048; const int ks = (c > 8 ? c - 8 : 0) * 64;
                sa.k1 = P + (r0 + ks) * 2048 + 928 + h * 64; sa.k1ld = 2048; sa.k1f32 = 0; sa.k2 = nullptr; sa.k2ld = 0;
                sa.vt = VTB + (size_t)(h * 64) * T + r0 + ks; sa.vtld = T; sa.nkeys = (c + 1) * 64 - ks; sa.kpos0 = ks;
                const bf16_t* q = P + (r0 + c * 64) * 2048 + 416 + h * 64; bf16_t* o = HO + (r0 + c * 64) * 1024 + 512 + h * 64;
                attn_item<2, 4, true>(q, q + 32 * 2048, 2048, 1, sa, sb, 0.125f, tbl, true, c * 64, false, 0.f, 0.f, o, o + 32 * 1024, 1024, lane, qbuf, ropeA);
            }
        }
    }
    }
}

DI void attn_odd(const int TID, KP p, int i, LAS unsigned char* lds) {
    const int lane = TID & 63, wid = TID >> 6;
    const bf16_t* P = (const bf16_t*)(p->ws + WS_P); const bf16_t* VTC = (const bf16_t*)(p->ws + WS_VTB); const bf16_t* VTCC = (const bf16_t*)(p->ws + WS_VTCC);
    bf16_t* HO = (bf16_t*)(p->ws + WS_HO);
    LAS float* tbl = (LAS float*)(lds + wid * 1280);
    LAS bf16x8* qbuf = (LAS bf16x8*)(lds + 16384 + wid * 12288); const f32x2* ropeA = (const f32x2*)(p->ws + WS_ROPEA);
    volatile LAS int* gword = (volatile LAS int*)(lds + 131072 + 64);
    const float* sinks = p->in[20] + i * 16;
    ASeg sa, sb; sa.k2 = nullptr; sa.k2ld = 0; sa.k1f32 = 0; sa.kpos0 = 0; sb = sa; sb.k1 = nullptr; sb.vt = nullptr; sb.k1ld = 0; sb.vtld = 0; sb.nkeys = 0;
    const int x0 = (int)(xb_xcc_id() & 7u);
    for (int xi = 0; xi < 8; ++xi) { const int x = (x0 + xi) & 7; unsigned* ctr = (unsigned*)(p->ws + WS_CTL) + ((2 * i + 1) * 8 + x) * 16;
    for (;;) {
        __syncthreads();
        if (TID == 0) *gword = (int)atomicAdd(ctr, 1u);
        __syncthreads();
        const int g = *gword;
        if (g >= 260) break;
        const int id = g * 8 + wid;
        if (id < 32) {
            const int b = x + 8 * (id >> 3), r = id & 7, kvh = r >> 2, hq0 = kvh * 8 + (r & 3) * 2; const size_t rn = (size_t)TP + b * 32;
            sa.k1 = p->in[6] + ((size_t)(i * 32 + b) * 128) * 128 + kvh * 64; sa.k1ld = 128; sa.k1f32 = 1; sa.vt = VTCC + ((size_t)(i * 32 + b) * 128 + kvh * 64) * 128; sa.vtld = 128; sa.nkeys = 128;
            sb.k1 = P + rn * 1280 + 1024 + kvh * 64; sb.k1ld = 1280; sb.k1f32 = 0; sb.vt = VTC + (size_t)(kvh * 64) * T + rn; sb.vtld = T; sb.nkeys = 32;
            const bf16_t* q = P + rn * 1280 + hq0 * 64; bf16_t* o = HO + rn * 1024 + hq0 * 64;
            attn_item<2, 4, true>(q, q + 64, 1280, 2, sa, sb, 0.125f, tbl, false, 0, true, sinks[hq0], sinks[hq0 + 1], o, o + 64, 1024, lane, qbuf, ropeA);
        } else {
            const int e = id - 32, r = e & 511, c = 8 * (3 - (e >> 9)) + 7 - (r & 7), pr = r >> 3, b = x + 8 * (pr >> 4), hq = pr & 15, kvh = hq >> 3; const size_t r0 = (size_t)b * 2048; const int ks = (c > 2 ? c - 2 : 0) * 64;
            sa.k1 = P + (r0 + ks) * 1280 + 1024 + kvh * 64; sa.k1ld = 1280; sa.k1f32 = 0; sa.vt = VTC + (size_t)(kvh * 64) * T + r0 + ks; sa.vtld = T; sa.nkeys = (c + 1) * 64 - ks;
            const bf16_t* q = P + (r0 + c * 64) * 1280 + hq * 64; bf16_t* o = HO + (r0 + c * 64) * 1024 + hq * 64;
            attn_item<2, 4, true>(q, q + 32 * 1280, 1280, 1, sa, sb, 0.125f, tbl, false, 0, true, sinks[hq], sinks[hq], o, o + 32 * 1024, 1024, lane, qbuf, ropeA);
        }
    }
    }
}

struct GJob { const bf16_t* A; const bf16_t* Bt; bf16_t* O; int M, N, K, lda, ldb, ldc, epi; };

DI int n_gjobs(int l, int s) { if (s == 3) return 2; if (s == 5) return (l & 1) ? 0 : 5; if (s == 1 || s == 10) return 12; if (s == 7) return 5; return 1; }

DI GJob make_gjob(KP p, int l, int s, int j) {
    GJob g; unsigned char* ws = p->ws; bf16_t* W = (bf16_t*)(ws + WS_W); const int i = l >> 1; const bool odd = l & 1;
    bf16_t* HO = (bf16_t*)(ws + WS_HO); bf16_t* P = (bf16_t*)(ws + WS_P);
    bf16_t* WM = odd ? W + W_ODB + i * W_OD : W + W_EVB + i * W_EV;
    g.epi = 0;
    if (s == 0 || s == 9) { const int lf = l * 2 + (s == 9); g.A = HO; g.Bt = W + lf * W_FFN + W_GU; g.O = (bf16_t*)(ws + WS_HH); g.M = T; g.N = 2 * DFF; g.K = DM; g.lda = DM; g.ldb = DM; g.ldc = DFF; g.epi = 1; }
    else if (s == 1 || s == 10) { const int lf = l * 2 + (s == 10); g.A = (bf16_t*)(ws + WS_HH); g.Bt = W + lf * W_FFN + W_D; g.O = (bf16_t*)(ws + WS_RF); g.M = TP; g.N = DM; g.K = DFF; g.lda = DFF; g.ldb = DFF; g.ldc = DM;
        if (j > 0) { g.A += (size_t)TP * DFF + (j - 1) * 256; g.Bt += (j - 1) * 256; g.O = (bf16_t*)(ws + WS_RSF) + (size_t)(j - 1) * TS * DM; g.M = TS; g.K = 256; } }
    else if (s == 3) {
        if (j == 0) { g.A = HO; g.Bt = WM + (odd ? WO_IN : WE_IN); g.O = P; g.M = T; g.N = odd ? 1280 : 2048; g.K = DM; g.lda = DM; g.ldb = DM; g.ldc = g.N; }
        else { g.A = WM + (odd ? WO_INV : WE_INV); g.Bt = HO; g.O = (bf16_t*)(ws + WS_VTB); g.M = odd ? 256 : 512; g.N = T; g.K = DM; g.lda = DM; g.ldb = DM; g.ldc = T; }
    } else if (s == 5) {
        bf16_t* CK = (bf16_t*)(ws + WS_CKVC) + (size_t)i * 32768 * 128;
        if (j == 0) { g.A = P; g.Bt = WM + WE_UQ; g.O = (bf16_t*)(ws + WS_QA); g.M = T; g.N = 768; g.K = 256; g.lda = 2048; g.ldb = 256; g.ldc = 768; }
        else if (j == 1) { g.A = P + 256; g.Bt = WM + WE_UK; g.O = (bf16_t*)(ws + WS_KN); g.M = T; g.N = 512; g.K = 256; g.lda = 2048; g.ldb = 256; g.ldc = 512; }
        else if (j == 2) { g.A = WM + WE_UV; g.Bt = P + 256; g.O = (bf16_t*)(ws + WS_VTA); g.M = 512; g.N = T; g.K = 256; g.lda = 256; g.ldb = 2048; g.ldc = T; }
        else if (j == 3) { g.A = CK; g.Bt = WM + WE_UK; g.O = (bf16_t*)(ws + WS_KNC); g.M = 32768; g.N = 512; g.K = 256; g.lda = 128; g.ldb = 256; g.ldc = 512; }
        else { g.A = WM + WE_UV; g.Bt = CK; g.O = (bf16_t*)(ws + WS_VTAC); g.M = 512; g.N = 32768; g.K = 256; g.lda = 256; g.ldb = 128; g.ldc = 32768; }
    } else { g.A = HO; g.Bt = WM + (odd ? WO_OUT : WE_OUT); g.O = (bf16_t*)(ws + WS_RM); g.M = TP; g.N = DM; g.K = DM; g.lda = DM; g.ldb = DM; g.ldc = DM;
        if (j > 0) { g.A += (size_t)TP * DM + (j - 1) * 256; g.Bt += (j - 1) * 256; g.O = (bf16_t*)(ws + WS_RSM) + (size_t)(j - 1) * TS * DM; g.M = TS; g.K = 256; } }
    return g;
}

DI void run_gemms(const int TID, const int BID, KP p, int l, int s, LAS unsigned char* lds) {
    const int nj = n_gjobs(l, s), G = gridDim.x; int rot = 0;
    for (int j = 0; j < nj; ++j) {
        const GJob gj = make_gjob(p, l, s, j);
        pg8::Gemm g; g.A = gj.A; g.Bt = gj.Bt; g.M = gj.M; g.N = gj.N; g.K = gj.K; g.lda = gj.lda; g.ldb = gj.ldb;
        pg8::StaticOrder S; int c = BID - rot; if (c < 0) c += G; S.init(gj.M, gj.N, G, c);
        if (gj.epi == 0) { pg8::EpiStore E; E.O = gj.O; E.ldc = gj.ldc; pg8::gemm_phase(TID, lds, g, S, E); }
        else { pg8::EpiSwiGLU E; E.O = gj.O; pg8::gemm_phase(TID, lds, g, S, E); }
        rot = (rot + S.nwg) % G;
    }
}

DI void phase0(const int TID, const int BID, KP p, LAS unsigned char* lds) {
    const size_t gtid = (size_t)BID * 512 + TID, gn = (size_t)gridDim.x * 512;
    {   f32x2* ra = (f32x2*)(p->ws + WS_ROPEA); f32x2* rc = (f32x2*)(p->ws + WS_ROPEC);
        for (size_t e = gtid; e < 2048 * 24; e += gn) { if (e < 2048 * 16) ra[e] = rope_entry((int)(e >> 4), (int)(e & 15), p->c16); else { const size_t f = e - 2048 * 16; rc[f] = rope_entry((int)(f >> 3), (int)(f & 7), p->c8); } } }
    {   bf16_t* ck = (bf16_t*)(p->ws + WS_CKVC); const float* s = p->in[2];
        for (size_t e = gtid; e < (size_t)2 * 32768 * 128 / 4; e += gn) { const f32x4 v = *(const f32x4*)(s + 4 * e); u32x2 w; w.x = pk_bf16(v[0], v[1]); w.y = pk_bf16(v[2], v[3]); *(u32x2*)(ck + 4 * e) = w; }
        if (gtid < 256) ck[(size_t)2 * 32768 * 128 + gtid] = 0;
        bf16_t* kp = (bf16_t*)(p->ws + WS_KPEC); const float* s2 = p->in[3];
        for (size_t e = gtid; e < (size_t)2 * 32768 * 32 / 4; e += gn) { const f32x4 v = *(const f32x4*)(s2 + 4 * e); u32x2 w; w.x = pk_bf16(v[0], v[1]); w.y = pk_bf16(v[2], v[3]); *(u32x2*)(kp + 4 * e) = w; } }
    int rot = 0;
    for (int jdx = 0; jdx < 36; ++jdx) { const TJ j = make_tj(p, jdx); tj_run(TID, BID, j, rot, (LAS float*)lds); }
    norm_phase(TID, BID, p, nullptr, nullptr, 0, nullptr, 0.f, p->in[8], true);
}

DI void run_step(const int TID, const int BID, KP p, int l, int s, LAS unsigned char* lds) {
    const float* g = p->in[8] + (size_t)l * 6 * DM; const int i = l >> 1; const bool odd = l & 1;
    if (s == 2) norm_phase(TID, BID, p, (const bf16_t*)(p->ws + WS_RF), (const bf16_t*)(p->ws + WS_RSF), 11, g + DM, 0.5f, g + 2 * DM, false);
    else if (s == 8) norm_phase(TID, BID, p, (const bf16_t*)(p->ws + WS_RM), (const bf16_t*)(p->ws + WS_RSM), 4, g + 3 * DM, 1.0f, g + 4 * DM, false);
    else if (s == 11) norm_phase(TID, BID, p, (const bf16_t*)(p->ws + WS_RF), (const bf16_t*)(p->ws + WS_RSF), 11, g + 5 * DM, 0.5f, l < 3 ? g + 6 * DM : nullptr, false);
    else if (s == 4) { if (odd) post_odd(TID, BID, p, i); else post_even(TID, BID, p, i); }
    else if (s == 6) { if (odd) attn_odd(TID, p, i, lds); else attn_even(TID, p, i, lds); }
    else run_gemms(TID, BID, p, l, s, lds);
}

__global__ void __launch_bounds__(512, 2) mega(Params p) {
    extern __shared__ __attribute__((aligned(16))) unsigned char shm[];
    LAS unsigned char* lds = (LAS unsigned char*)shm;
    cg::grid_group grid = cg::this_grid();
    const int ph_lo = p.ph_lo, ph_hi = p.ph_hi;
    volatile LAS unsigned* stw = (volatile LAS unsigned*)(lds + 131072);
    if (threadIdx.x < 4) stw[threadIdx.x] = 0u;
    __syncthreads();
    for (int ph = ph_lo; ph < ph_hi; ++ph) {
        KP kp = (KP)__builtin_amdgcn_kernarg_segment_ptr();
        asm volatile("" : "+s"(kp));
        int TID = threadIdx.x, BID = blockIdx.x;
        asm volatile("" : "+v"(TID)); asm volatile("" : "+s"(BID));
        if (ph == 0) phase0(TID, BID, kp, lds);
        else if (ph == NPH - 1) {
            const f32x4* src = (const f32x4*)(kp->ws + WS_HH); f32x4* dst = (f32x4*)kp->out;
            for (size_t e = (size_t)(T / 2) * DM / 4 + (size_t)BID * 512 + TID; e < (size_t)T * DM / 4; e += (size_t)gridDim.x * 512) dst[e] = src[e];
        }
        else run_step(TID, BID, kp, (ph - 1) / 12, (ph - 1) % 12, lds);
        const bool empty_step = ph > 0 && ph < NPH - 1 && ((ph - 1) % 12) == 5 && (((ph - 1) / 12) & 1);
        if (ph + 1 < ph_hi && !empty_step) {
            unsigned* bar = (unsigned*)(kp->ws + WS_BAR);
            if (ph == 0) { grid.sync(); if (threadIdx.x == 0) (void)xb_add(&bar[XB_XCNT(xb_xcc_id())], 1u); }
            else xcd_barrier(bar, stw);
        }
    }
}

#ifndef N_LAUNCH_MODE
#define N_LAUNCH_MODE 1
#endif

extern "C" void kernel_launch(void* const* d_in, const int* in_sizes, int n_in, void* d_out, int out_size, void* d_ws, size_t ws_size, hipStream_t stream) {
    constexpr size_t kDynLds = 131072 + 16;
    static int grid_blocks = 0;
    if (!grid_blocks) {
        int dev = 0, cus = 0, per_cu = 0;
        (void)hipGetDevice(&dev);
        (void)hipDeviceGetAttribute(&cus, hipDeviceAttributeMultiprocessorCount, dev);
        (void)hipFuncSetAttribute((const void*)mega, hipFuncAttributeMaxDynamicSharedMemorySize, (int)kDynLds);
        if (hipOccupancyMaxActiveBlocksPerMultiprocessor(&per_cu, (const void*)mega, 512, kDynLds) != hipSuccess || per_cu < 1) per_cu = 1;
        (void)hipGetLastError();
        grid_blocks = cus * 1;
        if (n_in != 22 || (size_t)out_size != O_END || ws_size < WS_END) fprintf(stderr, "kernel_launch: unexpected sizes n_in %d out %d ws %zu (need %zu)\n", n_in, out_size, ws_size, (size_t)WS_END);
    }
    (void)hipMemsetAsync((char*)d_ws + WS_CTL, 0, 4096, stream);
    (void)hipMemsetAsync((char*)d_ws + WS_BAR, 0, 16384, stream);
    Params p{};
    for (int i = 0; i < 22; ++i) p.in[i] = (const float*)d_in[i];
    p.out = (float*)d_out; p.ws = (unsigned char*)d_ws;
    p.c16 = std::pow(500000.0, -1.0 / 16.0); p.c8 = std::pow(500000.0, -1.0 / 8.0);
#if N_LAUNCH_MODE
    p.ph_lo = 0; p.ph_hi = NPH;
    void* args[] = {&p};
    hipError_t e = hipLaunchCooperativeKernel((const void*)mega, dim3(grid_blocks), dim3(512), args, kDynLds, stream);
    if (e != hipSuccess) fprintf(stderr, "cooperative launch failed: %s (grid %d)\n", hipGetErrorString(e), grid_blocks);
#else
    for (int ph = 0; ph < NPH; ++ph) {
        p.ph_lo = ph; p.ph_hi = ph + 1;
        void* args[] = {&p};
        hipError_t e = hipLaunchCooperativeKernel((const void*)mega, dim3(grid_blocks), dim3(512), args, kDynLds, stream);
        if (e != hipSuccess) { fprintf(stderr, "launch failed: %s\n", hipGetErrorString(e)); break; }
    }
#endif
}
```

```cpp
#include <hip/hip_runtime.h>
#include <hip/hip_cooperative_groups.h>
#include <cstdio>
#include <cmath>
namespace cg = cooperative_groups;

#define DI __device__ __forceinline__
#define LAS __attribute__((address_space(3)))
typedef unsigned short bf16_t;
typedef short bf16x8 __attribute__((ext_vector_type(8)));
typedef float f32x4 __attribute__((ext_vector_type(4)));
typedef float f32x2 __attribute__((ext_vector_type(2)));
typedef float f32x16 __attribute__((ext_vector_type(16)));
typedef unsigned u32x4 __attribute__((ext_vector_type(4)));
typedef unsigned u32x2 __attribute__((ext_vector_type(2)));
typedef __bf16 bf2_t __attribute__((ext_vector_type(2)));

constexpr int TP = 65536, TS = 1024, T = TP + TS;
constexpr int DM = 1024, DFF = 2816;
constexpr float EPS = 1e-6f;
constexpr float LOG2E = 1.4426950408889634f;
constexpr int NPH = 1 + 4 * 12 + 1;

constexpr size_t WS_CTL_OLD = 0;
constexpr size_t WS_ROPEA = 4096;
constexpr size_t WS_ROPEC = WS_ROPEA + 2048 * 16 * 8;
constexpr size_t WS_W = WS_ROPEC + 2048 * 8 * 8;
constexpr size_t W_FFN = 8650752, W_GU = 0, W_D = 5767168;
constexpr size_t W_EVB = 8 * W_FFN, W_EV = 4128768;
constexpr size_t WE_IN = 0, WE_INV = 2097152, WE_UQ = 2621440, WE_UK = 2818048, WE_UV = 2949120, WE_OUT = 3080192;
constexpr size_t W_ODB = W_EVB + 2 * W_EV, W_OD = 2621440;
constexpr size_t WO_IN = 0, WO_INV = 1310720, WO_OUT = 1572864;
constexpr size_t W_TOTAL = W_ODB + 2 * W_OD;
constexpr size_t WS_CKVC = WS_W + W_TOTAL * 2;
constexpr size_t WS_KPEC = WS_CKVC + (size_t)(2 * 32768 * 128 + 256) * 2;
constexpr size_t WS_VTBC = WS_KPEC + (size_t)2 * 32768 * 32 * 2;
constexpr size_t WS_VTCC = WS_VTBC + (size_t)64 * 512 * 512 * 2;
constexpr size_t WS_KNC = WS_VTCC + (size_t)64 * 128 * 128 * 2;
constexpr size_t WS_VTAC = WS_KNC + (size_t)32768 * 512 * 2;
constexpr size_t WS_HO = WS_VTAC + (size_t)32768 * 512 * 2;
constexpr size_t WS_REG = WS_HO + (size_t)T * 1024 * 2;
constexpr size_t WS_P = WS_REG;
constexpr size_t WS_QA = WS_P + (size_t)T * 2048 * 2;
constexpr size_t WS_KN = WS_QA + (size_t)T * 768 * 2;
constexpr size_t WS_VTA = WS_KN + (size_t)T * 512 * 2;
constexpr size_t WS_VTB = WS_VTA + (size_t)T * 512 * 2;
constexpr size_t WS_END = WS_VTB + (size_t)T * 512 * 2;
constexpr size_t WS_HH = WS_REG;
constexpr size_t WS_RF = WS_HH + (size_t)T * 2816 * 2;
constexpr size_t WS_RM = WS_REG;
constexpr size_t WS_RSF = WS_RF + (size_t)T * 1024 * 2;
constexpr size_t WS_RSM = WS_RM + (size_t)T * 1024 * 2;
static_assert(WS_RSF + (size_t)11 * 1024 * 1024 * 2 <= WS_END, "split region");
static_assert(WS_RF + (size_t)T * 1024 * 2 <= WS_END, "ffn region");
constexpr size_t WS_BAR = WS_END;
constexpr size_t WS_CTL = WS_BAR + 16384;
static_assert(WS_CTL + 4096 <= (size_t)1024 * 1024 * 1024, "workspace");

constexpr size_t O_Y = 0;
constexpr size_t O_CKVP = (size_t)T * 1024;
constexpr size_t O_KPEP = O_CKVP + (size_t)2 * 32 * 2048 * 128;
constexpr size_t O_BKP = O_KPEP + (size_t)2 * 32 * 2048 * 32;
constexpr size_t O_BVP = O_BKP + (size_t)2 * 32 * 512 * 512;
constexpr size_t O_SKP = O_BVP + (size_t)2 * 32 * 512 * 512;
constexpr size_t O_SVP = O_SKP + (size_t)2 * 32 * 128 * 128;
constexpr size_t O_CKVS = O_SVP + (size_t)2 * 32 * 128 * 128;
constexpr size_t O_KPES = O_CKVS + (size_t)2 * 32 * 32 * 128;
constexpr size_t O_BKS = O_KPES + (size_t)2 * 32 * 32 * 32;
constexpr size_t O_BVS = O_BKS + (size_t)2 * 32 * 32 * 512;
constexpr size_t O_SKS = O_BVS + (size_t)2 * 32 * 32 * 512;
constexpr size_t O_SVS = O_SKS + (size_t)2 * 32 * 32 * 128;
constexpr size_t O_END = O_SVS + (size_t)2 * 32 * 32 * 128;

struct Params {
    const float* in[22];
    float* out;
    unsigned char* ws;
    double c16, c8;
    int ph_lo, ph_hi;
};

typedef const __attribute__((address_space(4))) Params* KP;
DI unsigned pk_bf16(float lo, float hi) { f32x2 v = {lo, hi}; bf2_t r = __builtin_convertvector(v, bf2_t); return __builtin_bit_cast(unsigned, r); }
DI float bf_lo(unsigned w) { return __uint_as_float(w << 16); }
DI float bf_hi(unsigned w) { return __uint_as_float(w & 0xffff0000u); }
DI float bf2f(bf16_t b) { return __uint_as_float((unsigned)b << 16); }
DI bf16_t f2bf(float f) { return (bf16_t)(pk_bf16(f, 0.f) & 0xffffu); }
DI float wave_sum(float v) {
#pragma unroll
    for (int o = 32; o; o >>= 1) v += __shfl_xor(v, o);
    return v;
}


#define XB_TMO      128
#define XB_XCNT(j)  (256  + 64 * (j))
#define XB_XSUB(j)  (1280 + 64 * (j))
#define XB_XGEN(j)  (2304 + 64 * (j))
#define XB_TOP      3328
#define XB_TOPGEN   3392
#define XCD_BAR_WORDS 3456
#define XB_SPIN_CAP (1u << 20)
DI unsigned xb_ld(unsigned* p)              { return __hip_atomic_load(p, __ATOMIC_RELAXED, __HIP_MEMORY_SCOPE_AGENT); }
DI unsigned xb_add(unsigned* p, unsigned v) { return __hip_atomic_fetch_add(p, v, __ATOMIC_RELAXED, __HIP_MEMORY_SCOPE_AGENT); }
DI unsigned xb_xcc_id() { return (unsigned)__builtin_amdgcn_s_getreg((3 << 11) | 20) & 0xFu; }
#define XB_SPIN(cond, bar) do { unsigned _sp = 0; while (cond) { __builtin_amdgcn_s_sleep(1); \
    if ((++_sp & 255u) == 0u) { if (xb_ld(&(bar)[XB_TMO])) break; if (_sp > XB_SPIN_CAP) { atomicAdd(&(bar)[XB_TMO], 1u); break; } } } } while (0)
DI void xcd_barrier_complete(unsigned* bar, unsigned x, unsigned& nloc, unsigned& nx) {
    const unsigned G = gridDim.x;
    unsigned sum, cnt, mine, sp = 0u;
    for (;;) {
        sum = 0u; cnt = 0u; mine = 0u;
#pragma unroll
        for (unsigned j = 0; j < 16; ++j) { const unsigned c = xb_ld(&bar[XB_XCNT(j)]); sum += c; cnt += (c > 0u) ? 1u : 0u; mine = (j == x) ? c : mine; }
        if (sum == G) break;
        __builtin_amdgcn_s_sleep(1);
        if ((++sp & 255u) == 0u) { if (xb_ld(&bar[XB_TMO])) break; if (sp > XB_SPIN_CAP) { atomicAdd(&bar[XB_TMO], 1u); break; } }
    }
    nloc = mine > 0u ? mine : 1u; nx = cnt > 0u ? cnt : 1u;
}
DI void xcd_barrier(unsigned* bar, volatile LAS unsigned* st) {
    asm volatile("s_waitcnt vmcnt(0)" ::: "memory");
    __syncthreads();
    if (threadIdx.x == 0) {
        const unsigned x = xb_xcc_id();
        __builtin_amdgcn_s_waitcnt(0);
        unsigned nloc = st[0], nx = st[1];
        if (nloc == 0u) { xcd_barrier_complete(bar, x, nloc, nx); st[0] = nloc; st[1] = nx; }
        const unsigned old = xb_add(&bar[XB_XSUB(x)], 1u);
        const unsigned gen = old / nloc;
        if (old + 1u == (gen + 1u) * nloc) {
            __builtin_amdgcn_fence(__ATOMIC_RELEASE, "agent");
            asm volatile("s_waitcnt vmcnt(0)" ::: "memory");
            const unsigned og = xb_add(&bar[XB_TOP], 1u);
            const unsigned tg = og / nx;
            if (og + 1u == (tg + 1u) * nx) xb_add(&bar[XB_TOPGEN], 1u);
            else XB_SPIN(xb_ld(&bar[XB_TOPGEN]) == tg, bar);
            __builtin_amdgcn_fence(__ATOMIC_ACQUIRE, "agent");
            xb_add(&bar[XB_XGEN(x)], 1u);
            asm volatile("s_waitcnt vmcnt(0)" ::: "memory");
        } else {
            XB_SPIN(xb_ld(&bar[XB_XGEN(x)]) == gen, bar);
            __builtin_amdgcn_fence(__ATOMIC_ACQUIRE, "agent");
            asm volatile("s_waitcnt vmcnt(0)" ::: "memory");
        }
    }
    __syncthreads();
}

namespace pg8 {
constexpr int BM = 256, BK = 64, HALF = 128, HTB = HALF * BK * 2, STAGE_BYTES = 8 * HTB, NXCD = 8, WGM = 8;
DI int lds_byte(int r, int c) { const int st = (r >> 4) * 2 + (c >> 5), rr = r & 15, cc = c & 31, ob = rr * 64 + cc * 2; return st * 1024 + (ob ^ (((ob >> 9) & 1) << 5)); }
DI void stage_rc(int b, int& R, int& C) { const int st = b / 1024, sb = b % 1024, swz = sb ^ (((sb >> 9) & 1) << 5); R = (st >> 1) * 16 + swz / 64; C = (st & 1) * 32 + (swz % 64) / 2; }
DI int perm32(int rho) { const int n = rho >> 4, i = rho & 15; return 8 * (i >> 2) + 4 * n + (i & 3); }
struct Unit { int pm, pn; };
struct Gemm { const bf16_t* A; const bf16_t* Bt; int M, N, K, lda, ldb; };
struct StaticOrder {
    int nM, nN, nwg, G, c;
    DI void init(int M, int N, int G_, int c_) { nM = M / BM; nN = N / BM; nwg = nM * nN; G = G_; c = c_; }
    DI bool next(int i, Unit& u) const {
        const long L = (long)i * G + c; if (L >= nwg) return false;
        int wgid = (int)L; { const int q = nwg / NXCD, r = nwg % NXCD, xcd = wgid % NXCD, off = wgid / NXCD; wgid = (xcd < r ? xcd * (q + 1) : r * (q + 1) + (xcd - r) * q) + off; }
        const int nig = WGM * nN, gid = wgid / nig, fm = gid * WGM, gsz = (nM - fm) < WGM ? (nM - fm) : WGM;
        u.pm = fm + ((wgid % nig) % gsz); u.pn = (wgid % nig) / gsz; return true;
    }
};

template <class Epi>
DI void gemm_phase(const int TID, LAS unsigned char* lds, const Gemm g, const StaticOrder& S, const Epi& E) {
    const int tid = TID, wid = __builtin_amdgcn_readfirstlane(tid >> 6), lane = tid & 63, wr = wid >> 2, wc = wid & 3, fr = lane & 15, fq = lane >> 4;
    const int K = g.K, nt = K / BK;
    unsigned voffA[2], voffB[2];
#pragma unroll
    for (int i = 0; i < 2; ++i) { int R, C; stage_rc(tid * 16 + i * 8192, R, C); const int Rb = (R & ~31) + perm32(R & 31);
        voffA[i] = (unsigned)(R * g.lda + C) * 2u; voffB[i] = (unsigned)(Rb * g.ldb + C) * 2u; }
    const size_t kstep = (size_t)(BK * 2);
    const size_t hstepA = (size_t)HALF * g.lda * 2, hstepB = (size_t)HALF * g.ldb * 2;
    const size_t tstepA = 2 * hstepA, tstepB = 2 * hstepB;
    const unsigned ldsw = (unsigned)wid * 1024u;
    const int aoff = lds_byte(wr * 64 + fr, fq * 8), boff = lds_byte(wc * 32 + fr, fq * 8);
#define PG8_SA(b, h) (((b) * 2 + (h)) * HTB)
#define PG8_SB(b, h) ((4 + (b) * 2 + (h)) * HTB)
#define PG8_STAGE(bufoff, gbase, voff) do { _Pragma("unroll") for (int _i = 0; _i < 2; ++_i) \
        __builtin_amdgcn_global_load_lds((const unsigned*)((const char*)(gbase) + (voff)[_i]), (LAS unsigned*)(lds + (bufoff) + ldsw + _i * 8192), 16, 0, 0); } while (0)
#define PG8_LDA(dst, b, h) do { _Pragma("unroll") for (int m = 0; m < 4; ++m) _Pragma("unroll") for (int k = 0; k < 2; ++k) dst[m][k] = *(const LAS bf16x8*)(lds + PG8_SA(b, h) + aoff + m * 2048 + k * 1024); } while (0)
#define PG8_LDB(dst, b, h) do { _Pragma("unroll") for (int n = 0; n < 2; ++n) _Pragma("unroll") for (int k = 0; k < 2; ++k) dst[n][k] = *(const LAS bf16x8*)(lds + PG8_SB(b, h) + boff + n * 2048 + k * 1024); } while (0)
#define PG8_MMA(ai, bj, At, Bt) do { __builtin_amdgcn_s_setprio(1); _Pragma("unroll") for (int m = 0; m < 4; ++m) _Pragma("unroll") for (int n = 0; n < 2; ++n) _Pragma("unroll") for (int k = 0; k < 2; ++k) \
        acc[ai][bj][m][n] = __builtin_amdgcn_mfma_f32_16x16x32_bf16(Bt[n][k], At[m][k], acc[ai][bj][m][n], 0, 0, 0); __builtin_amdgcn_s_setprio(0); } while (0)
#define PG8_WAIT_V(n) asm volatile("s_waitcnt vmcnt(" #n ")" ::: "memory")
#define PG8_WAIT_L(n) asm volatile("s_waitcnt lgkmcnt(" #n ")" ::: "memory")
#define PG8_BAR __builtin_amdgcn_s_barrier()
#define PG8_SCHED __builtin_amdgcn_sched_barrier(0)
    Unit cur, nxt; int ui = 0;
    if (!S.next(0, cur)) return;
    f32x4 acc[2][2][4][2];
#pragma unroll
    for (int a = 0; a < 2; ++a)
#pragma unroll
        for (int b = 0; b < 2; ++b)
#pragma unroll
            for (int m = 0; m < 4; ++m)
#pragma unroll
                for (int n = 0; n < 2; ++n) acc[a][b][m][n] = (f32x4){0.f, 0.f, 0.f, 0.f};
    bf16x8 At[4][2], B0[2][2], B1[2][2];
    const char* cA = (const char*)g.A + (size_t)cur.pm * tstepA; const char* cB = (const char*)g.Bt + (size_t)cur.pn * tstepB;
    PG8_STAGE(PG8_SB(0, 0), cB, voffB); PG8_STAGE(PG8_SA(0, 0), cA, voffA); PG8_STAGE(PG8_SB(0, 1), cB + hstepB, voffB); PG8_STAGE(PG8_SA(0, 1), cA + hstepA, voffA);
    if (wr == 1) PG8_BAR;
    PG8_WAIT_V(4); PG8_BAR;
    PG8_STAGE(PG8_SB(1, 0), cB + kstep, voffB); PG8_STAGE(PG8_SA(1, 0), cA + kstep, voffA); PG8_STAGE(PG8_SB(1, 1), cB + hstepB + kstep, voffB);
    PG8_WAIT_V(6); PG8_BAR;
    for (;;) {
        const bool has_next = S.next(ui + 1, nxt);
        const char* nA = has_next ? (const char*)g.A + (size_t)nxt.pm * tstepA : cA; const char* nB = has_next ? (const char*)g.Bt + (size_t)nxt.pn * tstepB : cB;
        for (int t = 0; t < nt; t += 2) {
            const bool last = (t == nt - 2);
            const char* a1 = cA + (size_t)(t + 1) * kstep;
            const char* a2 = last ? nA : cA + (size_t)(t + 2) * kstep; const char* b2 = last ? nB : cB + (size_t)(t + 2) * kstep;
            const char* a3 = a2 + kstep; const char* b3 = b2 + kstep;
            PG8_LDB(B0, 0, 0); PG8_SCHED; PG8_LDA(At, 0, 0); PG8_STAGE(PG8_SA(1, 1), a1 + hstepA, voffA);
            PG8_WAIT_L(8); PG8_BAR; PG8_WAIT_L(0); PG8_MMA(0, 0, At, B0); PG8_BAR; PG8_SCHED;
            PG8_LDB(B1, 0, 1); PG8_STAGE(PG8_SB(0, 0), b2, voffB);
            PG8_BAR; PG8_WAIT_L(0); PG8_MMA(0, 1, At, B1); PG8_BAR;
            PG8_LDA(At, 0, 1); PG8_STAGE(PG8_SA(0, 0), a2, voffA);
            PG8_BAR; PG8_WAIT_L(0); PG8_MMA(1, 0, At, B0); PG8_BAR; PG8_SCHED;
            PG8_STAGE(PG8_SB(0, 1), b2 + hstepB, voffB);
            PG8_WAIT_V(6); PG8_BAR; PG8_MMA(1, 1, At, B1); PG8_BAR;
            PG8_LDB(B0, 1, 0); PG8_SCHED; PG8_LDA(At, 1, 0); PG8_STAGE(PG8_SA(0, 1), a2 + hstepA, voffA);
            PG8_WAIT_L(8); PG8_BAR; PG8_WAIT_L(0); PG8_MMA(0, 0, At, B0); PG8_BAR; PG8_SCHED;
            PG8_LDB(B1, 1, 1); PG8_STAGE(PG8_SB(1, 0), b3, voffB);
            PG8_BAR; PG8_WAIT_L(0); PG8_MMA(0, 1, At, B1); PG8_BAR;
            PG8_LDA(At, 1, 1); PG8_STAGE(PG8_SA(1, 0), a3, voffA);
            PG8_BAR; PG8_WAIT_L(0); PG8_MMA(1, 0, At, B0); PG8_BAR; PG8_SCHED;
            PG8_STAGE(PG8_SB(1, 1), b3 + hstepB, voffB);
            PG8_WAIT_V(6); PG8_BAR; PG8_MMA(1, 1, At, B1); PG8_BAR;
        }
        E(acc, cur, wr, wc, fr, fq);
        if (!has_next) break;
#pragma unroll
        for (int a = 0; a < 2; ++a)
#pragma unroll
            for (int b = 0; b < 2; ++b)
#pragma unroll
                for (int m = 0; m < 4; ++m)
#pragma unroll
                    for (int n = 0; n < 2; ++n) acc[a][b][m][n] = (f32x4){0.f, 0.f, 0.f, 0.f};
        cur = nxt; cA = nA; cB = nB; ++ui;
    }
    PG8_WAIT_V(0);
    if (wr == 0) PG8_BAR;
    PG8_BAR;
#undef PG8_SA
#undef PG8_SB
#undef PG8_STAGE
#undef PG8_LDA
#undef PG8_LDB
#undef PG8_MMA
#undef PG8_WAIT_V
#undef PG8_WAIT_L
#undef PG8_BAR
#undef PG8_SCHED
}

struct EpiStore {
    bf16_t* O; int ldc;
    DI void operator()(const f32x4 (&acc)[2][2][4][2], const Unit& u, int wr, int wc, int fr, int fq) const {
        const int row0 = u.pm * BM + wr * 64 + fr, col0 = u.pn * BM + wc * 32 + 8 * fq;
#pragma unroll
        for (int ai = 0; ai < 2; ++ai)
#pragma unroll
            for (int m = 0; m < 4; ++m) { bf16_t* rowp = O + (size_t)(row0 + ai * HALF + m * 16) * ldc + col0;
#pragma unroll
                for (int bj = 0; bj < 2; ++bj) { const f32x4 v0 = acc[ai][bj][m][0], v1 = acc[ai][bj][m][1];
                    u32x4 w; w.x = pk_bf16(v0[0], v0[1]); w.y = pk_bf16(v0[2], v0[3]); w.z = pk_bf16(v1[0], v1[1]); w.w = pk_bf16(v1[2], v1[3]);
                    *(u32x4*)(rowp + bj * HALF) = w; } }
    }
};
DI float silu_mul(float g, float u) { return g * __builtin_amdgcn_rcpf(1.0f + __expf(-g)) * u; }
struct EpiSwiGLU {
    bf16_t* O;
    DI void operator()(const f32x4 (&acc)[2][2][4][2], const Unit& u, int wr, int wc, int fr, int fq) const {
        const int row0 = u.pm * BM + wr * 64 + fr, col0 = u.pn * HALF + wc * 32 + 8 * fq;
#pragma unroll
        for (int ai = 0; ai < 2; ++ai)
#pragma unroll
            for (int m = 0; m < 4; ++m) { bf16_t* rowp = O + (size_t)(row0 + ai * HALF + m * 16) * DFF + col0;
                const f32x4 g0 = acc[ai][0][m][0], g1 = acc[ai][0][m][1], u0 = acc[ai][1][m][0], u1 = acc[ai][1][m][1];
                u32x4 w; w.x = pk_bf16(silu_mul(g0[0], u0[0]), silu_mul(g0[1], u0[1])); w.y = pk_bf16(silu_mul(g0[2], u0[2]), silu_mul(g0[3], u0[3]));
                w.z = pk_bf16(silu_mul(g1[0], u1[0]), silu_mul(g1[1], u1[1])); w.w = pk_bf16(silu_mul(g1[2], u1[2]), silu_mul(g1[3], u1[3]));
                *(u32x4*)rowp = w; }
    }
};
}

struct TJ { const float* s0; const float* s1; bf16_t* dst; int ld, Ks, Nd, Kd, mode, colbase, nvalid, nbatch; size_t sstride, dstride; };

DI TJ make_tj(KP p, int jdx) {
    TJ j; j.s1 = nullptr; j.mode = 0; j.colbase = 0; j.nbatch = 1; j.sstride = 0; j.dstride = 0;
    bf16_t* W = (bf16_t*)(p->ws + WS_W);
    if (jdx < 16) {
        const int lf = jdx >> 1;
        if ((jdx & 1) == 0) { j.s0 = p->in[9] + (size_t)lf * DM * DFF; j.s1 = p->in[10] + (size_t)lf * DM * DFF; j.dst = W + lf * W_FFN + W_GU; j.ld = DFF; j.Ks = DM; j.Nd = 2 * DFF; j.Kd = DM; j.mode = 1; j.nvalid = 2 * DFF; }
        else { j.s0 = p->in[11] + (size_t)lf * DM * DFF; j.dst = W + lf * W_FFN + W_D; j.ld = DM; j.Ks = DFF; j.Nd = DM; j.Kd = DFF; j.nvalid = DM; }
    } else if (jdx < 28) {
        const int i = (jdx - 16) / 6, k = (jdx - 16) % 6; bf16_t* B = W + W_EVB + i * W_EV;
        if (k == 0) { j.s0 = p->in[12] + (size_t)i * DM * 1952; j.dst = B + WE_IN; j.ld = 1952; j.Ks = DM; j.Nd = 2048; j.Kd = DM; j.nvalid = 1952; }
        else if (k == 1) { j.s0 = p->in[12] + (size_t)i * DM * 1952; j.dst = B + WE_INV; j.ld = 1952; j.Ks = DM; j.Nd = 512; j.Kd = DM; j.colbase = 1440; j.nvalid = 512; }
        else if (k == 2) { j.s0 = p->in[14] + (size_t)i * 256 * 768; j.dst = B + WE_UQ; j.ld = 768; j.Ks = 256; j.Nd = 768; j.Kd = 256; j.nvalid = 768; }
        else if (k == 3) { j.s0 = p->in[16] + (size_t)i * 128 * 1024; j.dst = B + WE_UK; j.ld = 1024; j.Ks = 128; j.Nd = 512; j.Kd = 256; j.mode = 2; j.colbase = 0; j.nvalid = 512; }
        else if (k == 4) { j.s0 = p->in[16] + (size_t)i * 128 * 1024; j.dst = B + WE_UV; j.ld = 1024; j.Ks = 128; j.Nd = 512; j.Kd = 256; j.mode = 2; j.colbase = 64; j.nvalid = 512; }
        else { j.s0 = p->in[18] + (size_t)i * DM * DM; j.dst = B + WE_OUT; j.ld = DM; j.Ks = DM; j.Nd = DM; j.Kd = DM; j.nvalid = DM; }
    } else if (jdx < 34) {
        const int i = (jdx - 28) / 3, k = (jdx - 28) % 3; bf16_t* B = W + W_ODB + i * W_OD;
        if (k == 0) { j.s0 = p->in[19] + (size_t)i * DM * 1280; j.dst = B + WO_IN; j.ld = 1280; j.Ks = DM; j.Nd = 1280; j.Kd = DM; j.nvalid = 1280; }
        else if (k == 1) { j.s0 = p->in[19] + (size_t)i * DM * 1280; j.dst = B + WO_INV; j.ld = 1280; j.Ks = DM; j.Nd = 256; j.Kd = DM; j.colbase = 1152; j.nvalid = 128; }
        else { j.s0 = p->in[21] + (size_t)i * DM * DM; j.dst = B + WO_OUT; j.ld = DM; j.Ks = DM; j.Nd = DM; j.Kd = DM; j.nvalid = DM; }
    } else if (jdx == 34) {
        j.s0 = p->in[5]; j.dst = (bf16_t*)(p->ws + WS_VTBC); j.ld = 512; j.Ks = 512; j.Nd = 512; j.Kd = 512; j.nvalid = 512; j.nbatch = 64; j.sstride = 512 * 512; j.dstride = 512 * 512;
    } else {
        j.s0 = p->in[7]; j.dst = (bf16_t*)(p->ws + WS_VTCC); j.ld = 128; j.Ks = 128; j.Nd = 128; j.Kd = 128; j.nvalid = 128; j.nbatch = 64; j.sstride = 128 * 128; j.dstride = 128 * 128;
    }
    return j;
}

DI void tj_run(const int TID, const int BID, const TJ& j, int& rot, LAS float* tile) {
    const int G = gridDim.x, tid = TID;
    const int tk = j.Kd / 64, per = (j.Nd / 64) * tk, nt = per * j.nbatch;
    int first = BID - rot; if (first < 0) first += G;
    const int nl = tid & 63, kl = tid >> 6;
    float v[8];
#define TJ_LOAD(t_) do { const int batch = (t_) / per, r = (t_) % per, n0 = (r / tk) * 64, k0 = (r % tk) * 64, n = n0 + nl; \
        const float* src = j.s0; int col; \
        if (j.mode == 0) col = n < j.nvalid ? j.colbase + n : -1; \
        else if (j.mode == 1) { const int pn = n >> 8, bj = (n >> 7) & 1, jj = n & 127; if (bj) src = j.s1; col = pn * 128 + jj; } \
        else col = (n >> 6) * 128 + (n & 63) + j.colbase; \
        src += (size_t)batch * j.sstride; \
        _Pragma("unroll") for (int i = 0; i < 8; ++i) { const int k = k0 + kl + 8 * i; v[i] = 0.f; if (col >= 0 && k < j.Ks) v[i] = src[(size_t)k * j.ld + col]; } } while (0)
    if (first < nt) TJ_LOAD(first);
    for (int t = first; t < nt; t += G) {
        const int batch = t / per, r = t % per, n0 = (r / tk) * 64, k0 = (r % tk) * 64;
#pragma unroll
        for (int i = 0; i < 8; ++i) tile[(kl + 8 * i) * 65 + nl] = v[i];
        __syncthreads();
        if (t + G < nt) TJ_LOAD(t + G);
        {   const int kp = (tid & 31) * 2, nl2 = tid >> 5; bf16_t* d = j.dst + (size_t)batch * j.dstride;
#pragma unroll
            for (int i = 0; i < 4; ++i) { const int n = nl2 + 16 * i; const float v0 = tile[kp * 65 + n], v1 = tile[(kp + 1) * 65 + n];
                *(unsigned*)(d + (size_t)(n0 + n) * j.Kd + k0 + kp) = pk_bf16(v0, v1); }
        }
        __syncthreads();
    }
#undef TJ_LOAD
    rot = (rot + nt) % G;
}

DI f32x2 rope_entry(int pos, int j, double c) {
    double inv = 1.0; for (int i = 0; i < j; ++i) inv *= c;
    const double a = (double)pos * inv;
    const double k = rint(a * 0.15915494309189535);
    const double r = fma(-k, 6.283185307179586, a) - k * 2.4492935982947064e-16;
    const double r2 = r * r;
    double s = 1.0 / 121645100408832000.0, cc = 1.0 / 2432902008176640000.0;
    s = s * r2 * -1.0 + 1.0 / 355687428096000.0;  cc = cc * r2 * -1.0 + 1.0 / 6402373705728000.0;
    s = s * r2 * -1.0 + 1.0 / 1307674368000.0;    cc = cc * r2 * -1.0 + 1.0 / 20922789888000.0;
    s = s * r2 * -1.0 + 1.0 / 6227020800.0;       cc = cc * r2 * -1.0 + 1.0 / 87178291200.0;
    s = s * r2 * -1.0 + 1.0 / 39916800.0;         cc = cc * r2 * -1.0 + 1.0 / 479001600.0;
    s = s * r2 * -1.0 + 1.0 / 362880.0;           cc = cc * r2 * -1.0 + 1.0 / 3628800.0;
    s = s * r2 * -1.0 + 1.0 / 5040.0;             cc = cc * r2 * -1.0 + 1.0 / 40320.0;
    s = s * r2 * -1.0 + 1.0 / 120.0;              cc = cc * r2 * -1.0 + 1.0 / 720.0;
    s = s * r2 * -1.0 + 1.0 / 6.0;                cc = cc * r2 * -1.0 + 1.0 / 24.0;
    s = s * r2 * -1.0 + 1.0;                      cc = cc * r2 * -1.0 + 0.5;
    s = s * r;                                    cc = cc * r2 * -1.0 + 1.0;
    f32x2 o; o.x = (float)cc; o.y = (float)s; return o;
}

DI void norm_phase(const int TID, const int BID, KP p, const bf16_t* R, const bf16_t* Rs, int nsp, const float* gpost, float cmul, const float* gpre, bool first) {
    const int lane = TID & 63, gw = BID * 8 + (TID >> 6), nw = gridDim.x * 8;
    bf16_t* XB = (bf16_t*)p->out + (size_t)T * DM;
    float* YT = (float*)(p->ws + WS_HH);
    const bool lastp = !first && gpre == nullptr;
    bf16_t* H = (bf16_t*)(p->ws + WS_HO);
    constexpr int NR = 1;
    for (int row0 = gw; row0 < T; row0 += NR * nw) {
        int rows[NR]; bool has[NR];
#pragma unroll
        for (int u = 0; u < NR; ++u) { has[u] = row0 + u * nw < T; rows[u] = has[u] ? row0 + u * nw : row0; }
        f32x4 xv[NR][4], rv[NR][4];
#pragma unroll
        for (int u = 0; u < NR; ++u) { const int row = rows[u];
            if (first) { const float* src = row < TP ? p->in[0] + (size_t)row * DM : p->in[1] + (size_t)(row - TP) * DM;
#pragma unroll
                for (int i = 0; i < 4; ++i) xv[u][i] = *(const f32x4*)(src + 4 * lane + 256 * i); }
            else {
#pragma unroll
                for (int i = 0; i < 4; ++i) { const u32x2 w = *(const u32x2*)(XB + (size_t)row * DM + 4 * lane + 256 * i); xv[u][i] = (f32x4){bf_lo(w.x), bf_hi(w.x), bf_lo(w.y), bf_hi(w.y)}; } }
            if (!first) {
                if (row < TP) {
#pragma unroll
                    for (int i = 0; i < 4; ++i) { const u32x2 w = *(const u32x2*)(R + (size_t)row * DM + 4 * lane + 256 * i); rv[u][i] = (f32x4){bf_lo(w.x), bf_hi(w.x), bf_lo(w.y), bf_hi(w.y)}; }
                } else {
#pragma unroll
                    for (int i = 0; i < 4; ++i) rv[u][i] = (f32x4){0.f, 0.f, 0.f, 0.f};
                    for (int sp = 0; sp < nsp; ++sp) {
#pragma unroll
                        for (int i = 0; i < 4; ++i) { const u32x2 w = *(const u32x2*)(Rs + ((size_t)sp * TS + (row - TP)) * DM + 4 * lane + 256 * i);
                            rv[u][i] += (f32x4){bf_lo(w.x), bf_hi(w.x), bf_lo(w.y), bf_hi(w.y)}; } }
                }
            }
        }
#pragma unroll
        for (int u = 0; u < NR; ++u) { const int row = rows[u]; const bool act = has[u];
            if (!first) {
                float ss = 0.f;
#pragma unroll
                for (int i = 0; i < 4; ++i) ss += rv[u][i][0] * rv[u][i][0] + rv[u][i][1] * rv[u][i][1] + rv[u][i][2] * rv[u][i][2] + rv[u][i][3] * rv[u][i][3];
                ss = wave_sum(ss);
                const float rs = rsqrtf(ss * (1.0f / DM) + EPS) * cmul;
#pragma unroll
                for (int i = 0; i < 4; ++i) { const f32x4 g = *(const f32x4*)(gpost + 4 * lane + 256 * i); xv[u][i] += rv[u][i] * g * rs; }
            }
            if (act) {
                if (lastp) { float* yd = row < T / 2 ? p->out : YT;
#pragma unroll
                    for (int i = 0; i < 4; ++i) *(f32x4*)(yd + (size_t)row * DM + 4 * lane + 256 * i) = xv[u][i]; }
                else {
#pragma unroll
                    for (int i = 0; i < 4; ++i) { u32x2 w; w.x = pk_bf16(xv[u][i][0], xv[u][i][1]); w.y = pk_bf16(xv[u][i][2], xv[u][i][3]); *(u32x2*)(XB + (size_t)row * DM + 4 * lane + 256 * i) = w; } } }
            if (gpre) {
                float ss = 0.f;
#pragma unroll
                for (int i = 0; i < 4; ++i) ss += xv[u][i][0] * xv[u][i][0] + xv[u][i][1] * xv[u][i][1] + xv[u][i][2] * xv[u][i][2] + xv[u][i][3] * xv[u][i][3];
                ss = wave_sum(ss);
                const float rs = rsqrtf(ss * (1.0f / DM) + EPS);
                if (act) {
#pragma unroll
                    for (int i = 0; i < 4; ++i) { const f32x4 g = *(const f32x4*)(gpre + 4 * lane + 256 * i); const f32x4 o = xv[u][i] * g * rs;
                        u32x2 w; w.x = pk_bf16(o[0], o[1]); w.y = pk_bf16(o[2], o[3]); *(u32x2*)(H + (size_t)row * DM + 4 * lane + 256 * i) = w; } }
            }
        }
    }
}

DI void post_even(const int TID, const int BID, KP p, int i) {
    const int lane = TID & 63, gw = BID * 8 + (TID >> 6), nw = gridDim.x * 8;
    bf16_t* P = (bf16_t*)(p->ws + WS_P);
    const float* qn = p->in[13] + i * 256; const float* kvn = p->in[15] + i * 128;
    const f32x2* ropeA = (const f32x2*)(p->ws + WS_ROPEA);
    const f32x4 gq = *(const f32x4*)(qn + 4 * lane); const f32x2 gk = *(const f32x2*)(kvn + 2 * lane);
    for (int row = gw; row < T; row += nw) {
        const bool smp = row >= TP; const int rs_ = row - TP;
        const int b = smp ? (rs_ >> 5) : (row >> 11), t = smp ? (rs_ & 31) : (row & 2047), pos = smp ? 1024 + t : t, Tl = smp ? 32 : 2048;
        bf16_t* Pr = P + (size_t)row * 2048;
        const bool wout = smp || t >= 1536;
        const u32x2 wq = *(const u32x2*)(Pr + 4 * lane);
        const unsigned wk = *(const unsigned*)(Pr + 256 + 2 * lane);
        const float vpe = bf2f(Pr[384 + (lane & 31)]);
        const f32x2 cs = ropeA[pos * 16 + (lane & 15)];
        u32x4 kw = {0u, 0u, 0u, 0u}, vw = {0u, 0u, 0u, 0u};
        if (wout) { kw = *(const u32x4*)(Pr + 928 + 8 * lane); vw = *(const u32x4*)(Pr + 1440 + 8 * lane); }
        f32x4 v = {bf_lo(wq.x), bf_hi(wq.x), bf_lo(wq.y), bf_hi(wq.y)};
        float v0 = bf_lo(wk), v1 = bf_hi(wk);
        float ssq = v[0] * v[0] + v[1] * v[1] + v[2] * v[2] + v[3] * v[3], ssk = v0 * v0 + v1 * v1;
#pragma unroll
        for (int o = 32; o; o >>= 1) { ssq += __shfl_xor(ssq, o); ssk += __shfl_xor(ssk, o); }
        const float rq = rsqrtf(ssq * (1.0f / 256) + EPS), rk = rsqrtf(ssk * (1.0f / 128) + EPS);
        v = v * gq * rq; v0 = v0 * gk.x * rk; v1 = v1 * gk.y * rk;
        const float pr = __shfl_xor(vpe, 16);
        const float ope = (lane & 16) ? vpe * cs.x + pr * cs.y : vpe * cs.x - pr * cs.y;
        { u32x2 o; o.x = pk_bf16(v[0], v[1]); o.y = pk_bf16(v[2], v[3]); *(u32x2*)(Pr + 4 * lane) = o; }
        *(unsigned*)(Pr + 256 + 2 * lane) = pk_bf16(v0, v1);
        { float* o = p->out + (smp ? O_CKVS : O_CKVP) + ((size_t)(i * 32 + b) * Tl + t) * 128 + 2 * lane; *(f32x2*)o = (f32x2){v0, v1}; }
        if (lane < 32) { Pr[384 + lane] = f2bf(ope); p->out[(smp ? O_KPES : O_KPEP) + ((size_t)(i * 32 + b) * Tl + t) * 32 + lane] = ope; }
        if (wout) {
            const int tr = smp ? t : t - 1536, Tb = smp ? 32 : 512;
            float* ok = p->out + (smp ? O_BKS : O_BKP) + ((size_t)(i * 32 + b) * Tb + tr) * 512 + 8 * lane;
            float* ov = p->out + (smp ? O_BVS : O_BVP) + ((size_t)(i * 32 + b) * Tb + tr) * 512 + 8 * lane;
            *(f32x4*)ok = (f32x4){bf_lo(kw.x), bf_hi(kw.x), bf_lo(kw.y), bf_hi(kw.y)}; *(f32x4*)(ok + 4) = (f32x4){bf_lo(kw.z), bf_hi(kw.z), bf_lo(kw.w), bf_hi(kw.w)};
            *(f32x4*)ov = (f32x4){bf_lo(vw.x), bf_hi(vw.x), bf_lo(vw.y), bf_hi(vw.y)}; *(f32x4*)(ov + 4) = (f32x4){bf_lo(vw.z), bf_hi(vw.z), bf_lo(vw.w), bf_hi(vw.w)}; }
    }
}

DI void post_odd(const int TID, const int BID, KP p, int i) {
    const int lane = TID & 63, gw = BID * 8 + (TID >> 6), nw = gridDim.x * 8;
    bf16_t* P = (bf16_t*)(p->ws + WS_P);
    const f32x2* ropeC = (const f32x2*)(p->ws + WS_ROPEC);
    for (int row = gw; row < T; row += nw) {
        const bool smp = row >= TP; const int rs_ = row - TP;
        const int b = smp ? (rs_ >> 5) : (row >> 11), t = smp ? (rs_ & 31) : (row & 2047), pos = smp ? 1024 + t : t;
        const bool wout = smp || t >= 1920; const int tr = smp ? t : t - 1920, Tb = smp ? 32 : 128;
        bf16_t* Pr = P + (size_t)row * 1280;
        float* ok = p->out + (smp ? O_SKS : O_SKP) + ((size_t)(i * 32 + b) * Tb + tr) * 128;
        float* ov = p->out + (smp ? O_SVS : O_SVP) + ((size_t)(i * 32 + b) * Tb + tr) * 128;
        const f32x2 cs = ropeC[pos * 8 + (lane & 7)];
        float vv[5]; unsigned vw = 0u, kw = 0u;
#pragma unroll
        for (int it = 0; it < 5; ++it) { const int e = lane + 64 * it; const int col = (e >> 4) * 64 + (e & 15); vv[it] = e < 288 ? bf2f(Pr[col]) : 0.f; }
        const int idx = 2 * lane, hd = idx / 48, jn = 16 + idx % 48;
        if (wout) { vw = *(const unsigned*)(Pr + 1152 + 2 * lane); if (lane < 48) kw = *(const unsigned*)(Pr + 1024 + hd * 64 + jn); }
#pragma unroll
        for (int it = 0; it < 5; ++it) {
            const int e = lane + 64 * it; const bool act = e < 288; const int head = e >> 4, jj = e & 15, col = head * 64 + jj;
            const float v = vv[it]; const float pr = __shfl_xor(v, 8);
            const float o = (jj & 8) ? v * cs.x + pr * cs.y : v * cs.x - pr * cs.y;
            if (act) { Pr[col] = f2bf(o); if (wout && head >= 16) ok[(head - 16) * 64 + jj] = o; }
        }
        if (wout) {
            *(f32x2*)(ov + 2 * lane) = (f32x2){bf_lo(vw), bf_hi(vw)};
            if (lane < 48) *(f32x2*)(ok + hd * 64 + jn) = (f32x2){bf_lo(kw), bf_hi(kw)};
        }
    }
}

struct ASeg { const void* k1; const bf16_t* k2; const bf16_t* vt; int k1ld, k2ld, k1f32; size_t vtld; int nkeys, kpos0; };

template <int NQT, int KS, bool QL>
DI void attn_item(const bf16_t* q0, const bf16_t* q1, int qld, int nseg, const ASeg& sa, const ASeg& sb, float scale,
                  const LAS float* tbl, bool has_bias, int qpos0, bool has_sink, float sink0, float sink1, bf16_t* o0, bf16_t* o1, int old, int lane,
                  LAS bf16x8* qbuf, const f32x2* ropeA) {
    const int lr = lane & 31, lh = lane >> 5;
    bf16x8 qf[QL ? 1 : NQT][QL ? 1 : KS];
#pragma unroll
    for (int qt = 0; qt < NQT; ++qt) {
        bf16x8 tq[KS];
#pragma unroll
        for (int ks = 0; ks < KS; ++ks) tq[ks] = *(const bf16x8*)((qt ? q1 : q0) + (size_t)lr * qld + 16 * ks + 8 * lh);
        if (KS == 6) {
            const f32x2* cs = ropeA + (qpos0 + 32 * qt + lr) * 16 + 8 * lh;
            const u32x4 a = __builtin_bit_cast(u32x4, tq[4]), b = __builtin_bit_cast(u32x4, tq[KS - 1]); u32x4 ra, rb;
#pragma unroll
            for (int w = 0; w < 4; ++w) { const f32x2 c0 = cs[2 * w], c1 = cs[2 * w + 1];
                const float x10 = bf_lo(a[w]), x11 = bf_hi(a[w]), x20 = bf_lo(b[w]), x21 = bf_hi(b[w]);
                ra[w] = pk_bf16(x10 * c0.x - x20 * c0.y, x11 * c1.x - x21 * c1.y); rb[w] = pk_bf16(x20 * c0.x + x10 * c0.y, x21 * c1.x + x11 * c1.y); }
            tq[4] = __builtin_bit_cast(bf16x8, ra); tq[KS - 1] = __builtin_bit_cast(bf16x8, rb);
        }
#pragma unroll
        for (int ks = 0; ks < KS; ++ks) { if (QL) qbuf[(qt * KS + ks) * 64 + lane] = tq[ks]; else qf[QL ? 0 : qt][QL ? 0 : ks] = tq[ks]; }
    }
    f32x16 O[2][NQT]; float mx[NQT], ls[NQT];
#pragma unroll
    for (int qt = 0; qt < NQT; ++qt) { mx[qt] = -1e30f; ls[qt] = 0.f;
#pragma unroll
        for (int dt = 0; dt < 2; ++dt)
#pragma unroll
            for (int r = 0; r < 16; ++r) O[dt][qt][r] = 0.f; }
    const float sl = scale * LOG2E;
    for (int sg = 0; sg < nseg; ++sg) {
        const void* k1 = sg ? sb.k1 : sa.k1; const bf16_t* k2 = sg ? sb.k2 : sa.k2; const bf16_t* vt = sg ? sb.vt : sa.vt;
        const int k1ld = sg ? sb.k1ld : sa.k1ld, k2ld = sg ? sb.k2ld : sa.k2ld, k1f32 = sg ? sb.k1f32 : sa.k1f32;
        const size_t vtld = sg ? sb.vtld : sa.vtld; const int nkeys = sg ? sb.nkeys : sa.nkeys, kpos0 = sg ? sb.kpos0 : sa.kpos0;
        for (int kb = 0; kb < nkeys; kb += 32) {
            int qo = lane; asm volatile("" : "+v"(qo));
            bf16x8 kf[KS];
#pragma unroll
            for (int ks = 0; ks < KS; ++ks) {
                if (ks < 4) {
                    if (k1f32) { const float* kp = (const float*)k1 + (size_t)(kb + lr) * k1ld + 16 * ks + 8 * lh; const f32x4 a = *(const f32x4*)kp, b = *(const f32x4*)(kp + 4);
                        u32x4 w; w.x = pk_bf16(a[0], a[1]); w.y = pk_bf16(a[2], a[3]); w.z = pk_bf16(b[0], b[1]); w.w = pk_bf16(b[2], b[3]); kf[ks] = __builtin_bit_cast(bf16x8, w); }
                    else kf[ks] = *(const bf16x8*)((const bf16_t*)k1 + (size_t)(kb + lr) * k1ld + 16 * ks + 8 * lh);
                } else kf[ks] = *(const bf16x8*)(k2 + (size_t)(kb + lr) * k2ld + 16 * (ks - 4) + 8 * lh);
            }
            bf16x8 vf[2][2];
#pragma unroll
            for (int dt = 0; dt < 2; ++dt)
#pragma unroll
                for (int st = 0; st < 2; ++st) { const bf16_t* vp = vt + (size_t)(32 * dt + lr) * vtld + kb + 16 * st + 4 * lh;
                    const u32x2 a = *(const u32x2*)vp, b = *(const u32x2*)(vp + 8); u32x4 w = {a.x, a.y, b.x, b.y}; vf[dt][st] = __builtin_bit_cast(bf16x8, w); }
            bf16x8 pf[NQT][2];
#pragma unroll
            for (int qt = 0; qt < NQT; ++qt) {
                f32x16 s;
#pragma unroll
                for (int r = 0; r < 16; ++r) s[r] = 0.f;
#pragma unroll
                for (int ks = 0; ks < KS; ++ks) { const bf16x8 qv = QL ? qbuf[(qt * KS + ks) * 64 + qo] : qf[QL ? 0 : qt][QL ? 0 : ks]; s = __builtin_amdgcn_mfma_f32_32x32x16_bf16(kf[ks], qv, s, 0, 0, 0); }
                if (has_bias) {
                    const int kp0 = kpos0 + kb;
                    if (qpos0 - (kp0 + 31) >= 128) { const float c = tbl[256] * LOG2E;
#pragma unroll
                        for (int r = 0; r < 16; ++r) s[r] = s[r] * sl + c; }
                    else { const int qp = qpos0 + 32 * qt + lr;
#pragma unroll
                        for (int r = 0; r < 16; ++r) { const int kp = kp0 + (r & 3) + 8 * (r >> 2) + 4 * lh; int idx = qp - kp + 128; idx = idx < 0 ? 0 : (idx > 256 ? 256 : idx);
                            s[r] = s[r] * sl + tbl[idx] * LOG2E; } }
                } else {
#pragma unroll
                    for (int r = 0; r < 16; ++r) s[r] *= sl;
                }
                float m = s[0];
#pragma unroll
                for (int r = 1; r < 16; ++r) m = fmaxf(m, s[r]);
                m = fmaxf(m, __shfl_xor(m, 32));
                const float mn = fmaxf(mx[qt], m), alpha = __builtin_amdgcn_exp2f(mx[qt] - mn); mx[qt] = mn;
                float psum = 0.f;
#pragma unroll
                for (int r = 0; r < 16; ++r) { s[r] = __builtin_amdgcn_exp2f(s[r] - mn); psum += s[r]; }
                ls[qt] = ls[qt] * alpha + psum;
#pragma unroll
                for (int dt = 0; dt < 2; ++dt)
#pragma unroll
                    for (int r = 0; r < 16; ++r) O[dt][qt][r] *= alpha;
#pragma unroll
                for (int st = 0; st < 2; ++st) { u32x4 w; w.x = pk_bf16(s[8 * st], s[8 * st + 1]); w.y = pk_bf16(s[8 * st + 2], s[8 * st + 3]);
                    w.z = pk_bf16(s[8 * st + 4], s[8 * st + 5]); w.w = pk_bf16(s[8 * st + 6], s[8 * st + 7]); pf[qt][st] = __builtin_bit_cast(bf16x8, w); }
            }
#pragma unroll
            for (int qt = 0; qt < NQT; ++qt)
#pragma unroll
                for (int dt = 0; dt < 2; ++dt)
#pragma unroll
                    for (int st = 0; st < 2; ++st) O[dt][qt] = __builtin_amdgcn_mfma_f32_32x32x16_bf16(vf[dt][st], pf[qt][st], O[dt][qt], 0, 0, 0);
        }
    }
#pragma unroll
    for (int qt = 0; qt < NQT; ++qt) {
        float l = ls[qt] + __shfl_xor(ls[qt], 32);
        if (has_sink) l += __builtin_amdgcn_exp2f((qt ? sink1 : sink0) * LOG2E - mx[qt]);
        const float inv = 1.0f / l;
        bf16_t* op = (qt ? o1 : o0) + (size_t)lr * old + 4 * lh;
#pragma unroll
        for (int dt = 0; dt < 2; ++dt)
#pragma unroll
            for (int g = 0; g < 4; ++g) { u32x2 w; w.x = pk_bf16(O[dt][qt][4 * g] * inv, O[dt][qt][4 * g + 1] * inv); w.y = pk_bf16(O[dt][qt][4 * g + 2] * inv, O[dt][qt][4 * g + 3] * inv);
                *(u32x2*)(op + 32 * dt + 8 * g) = w; }
    }
}

DI int next_item(unsigned* ctr, int lane) { int id = 0; if (lane == 0) id = (int)atomicAdd(ctr, 1u); return __builtin_amdgcn_readfirstlane(id); }

DI void attn_even(const int TID, KP p, int i, LAS unsigned char* lds) {
    const int lane = TID & 63, wid = TID >> 6;
    const bf16_t* P = (const bf16_t*)(p->ws + WS_P); const bf16_t* QA = (const bf16_t*)(p->ws + WS_QA); const bf16_t* KN = (const bf16_t*)(p->ws + WS_KN);
    const bf16_t* VTA = (const bf16_t*)(p->ws + WS_VTA); const bf16_t* VTB = (const bf16_t*)(p->ws + WS_VTB);
    const bf16_t* KNC = (const bf16_t*)(p->ws + WS_KNC); const bf16_t* VTAC = (const bf16_t*)(p->ws + WS_VTAC);
    const bf16_t* KPEC = (const bf16_t*)(p->ws + WS_KPEC); const bf16_t* VTBC = (const bf16_t*)(p->ws + WS_VTBC);
    bf16_t* HO = (bf16_t*)(p->ws + WS_HO);
    LAS float* tbl = (LAS float*)(lds + wid * 1280);
    LAS bf16x8* qbuf = (LAS bf16x8*)(lds + 16384 + wid * 12288); const f32x2* ropeA = (const f32x2*)(p->ws + WS_ROPEA);
    const float ascale = 0.10206207261596575f;
    ASeg sa, sb; sa.k2 = nullptr; sa.k2ld = 0; sa.k1f32 = 0; sa.kpos0 = 0; sb = sa; sb.k1 = nullptr; sb.vt = nullptr; sb.k1ld = 0; sb.vtld = 0; sb.nkeys = 0;
    const int x0 = (int)(xb_xcc_id() & 7u);
    for (int xi = 0; xi < 8; ++xi) { const int x = (x0 + xi) & 7; unsigned* ctr = (unsigned*)(p->ws + WS_CTL) + ((2 * i) * 8 + x) * 16;
    for (;;) {
        const int id = next_item(ctr, lane);
        if (id >= 2112) break;
        if (id < 1024) {
            const int r = id & 255, c = 8 * (3 - (id >> 8)) + 7 - (r & 7), pr = r >> 3, b = x + 8 * (pr >> 3), h = pr & 7; const size_t r0 = (size_t)b * 2048;
            sa.k1 = KN + r0 * 512 + h * 64; sa.k1ld = 512; sa.k1f32 = 0; sa.k2 = P + r0 * 2048 + 384; sa.k2ld = 2048; sa.vt = VTA + (size_t)(h * 64) * T + r0; sa.vtld = T; sa.nkeys = (c + 1) * 64; sa.kpos0 = 0;
            const bf16_t* q = QA + (r0 + c * 64) * 768 + h * 96; bf16_t* o = HO + (r0 + c * 64) * 1024 + h * 64;
            attn_item<2, 6, true>(q, q + 32 * 768, 768, 1, sa, sb, ascale, tbl, false, c * 64, false, 0.f, 0.f, o, o + 32 * 1024, 1024, lane, qbuf, ropeA);
        } else if (id < 1056) {
            const int e = id - 1024, b = x + 8 * (e >> 3), h = e & 7; const size_t rn = (size_t)TP + b * 32;
            sa.k1 = KNC + (size_t)(b * 1024) * 512 + h * 64; sa.k1ld = 512; sa.k1f32 = 0; sa.k2 = KPEC + ((size_t)i * 32768 + b * 1024) * 32; sa.k2ld = 32;
            sa.vt = VTAC + (size_t)(h * 64) * 32768 + b * 1024; sa.vtld = 32768; sa.nkeys = 1024; sa.kpos0 = 0;
            sb.k1 = KN + rn * 512 + h * 64; sb.k1ld = 512; sb.k1f32 = 0; sb.k2 = P + rn * 2048 + 384; sb.k2ld = 2048; sb.vt = VTA + (size_t)(h * 64) * T + rn; sb.vtld = T; sb.nkeys = 32; sb.kpos0 = 0;
            const bf16_t* q = QA + rn * 768 + h * 96; bf16_t* o = HO + rn * 1024 + h * 64;
            attn_item<1, 6, false>(q, q, 768, 2, sa, sb, ascale, tbl, false, 1024, false, 0.f, 0.f, o, o, 1024, lane, qbuf, ropeA);
        } else {
            const bool smp = id < 1088; int b, h, c = 0;
            if (smp) { const int e = id - 1056; b = x + 8 * (e >> 3); h = e & 7; } else { const int e = id - 1088, r = e & 255, pr = r >> 3; c = 8 * (3 - (e >> 8)) + 7 - (r & 7); b = x + 8 * (pr >> 3); h = pr & 7; }
            const float* rel = p->in[17] + (size_t)(i * 8 + h) * 257;
            for (int j = lane; j < 257; j += 64) tbl[j] = rel[j];
            if (smp) {
                const size_t rn = (size_t)TP + b * 32;
                sa.k1 = p->in[4] + ((size_t)(i * 32 + b) * 512) * 512 + h * 64; sa.k1ld = 512; sa.k1f32 = 1; sa.k2 = nullptr; sa.k2ld = 0;
                sa.vt = VTBC + ((size_t)(i * 32 + b) * 512 + h * 64) * 512; sa.vtld = 512; sa.nkeys = 512; sa.kpos0 = 512;
                sb.k1 = P + rn * 2048 + 928 + h * 64; sb.k1ld = 2048; sb.k1f32 = 0; sb.k2 = nullptr; sb.k2ld = 0; sb.vt = VTB + (size_t)(h * 64) * T + rn; sb.vtld = T; sb.nkeys = 32; sb.kpos0 = 1024;
                const bf16_t* q = P + rn * 2048 + 416 + h * 64; bf16_t* o = HO + rn * 1024 + 512 + h * 64;
                attn_item<1, 4, false>(q, q, 2048, 2, sa, sb, 0.125f, tbl, true, 1024, false, 0.f, 0.f, o, o, 1024, lane, qbuf, ropeA);
            } else {
                const size_t r0 = (size_t)b * 2048; const int ks = (c > 8 ? c - 8 : 0) * 64;
                sa.k1 = P + (r0 + ks) * 2048 + 928 + h * 64; sa.k1ld = 2048; sa.k1f32 = 0; sa.k2 = nullptr; sa.k2ld = 0;
                sa.vt = VTB + (size_t)(h * 64) * T + r0 + ks; sa.vtld = T; sa.nkeys = (c + 1) * 64 - ks; sa.kpos0 = ks;
                const bf16_t* q = P + (r0 + c * 64) * 2048 + 416 + h * 64; bf16_t* o = HO + (r0 + c * 64) * 1024 + 512 + h * 64;
                attn_item<2, 4, true>(q, q + 32 * 2048, 2048, 1, sa, sb, 0.125f, tbl, true, c * 64, false, 0.f, 0.f, o, o + 32 * 1024, 1024, lane, qbuf, ropeA);
            }
        }
    }
    }
}

DI void attn_odd(const int TID, KP p, int i, LAS unsigned char* lds) {
    const int lane = TID & 63, wid = TID >> 6;
    const bf16_t* P = (const bf16_t*)(p->ws + WS_P); const bf16_t* VTC = (const bf16_t*)(p->ws + WS_VTB); const bf16_t* VTCC = (const bf16_t*)(p->ws + WS_VTCC);
    bf16_t* HO = (bf16_t*)(p->ws + WS_HO);
    LAS float* tbl = (LAS float*)(lds + wid * 1280);
    LAS bf16x8* qbuf = (LAS bf16x8*)(lds + 16384 + wid * 12288); const f32x2* ropeA = (const f32x2*)(p->ws + WS_ROPEA);
    const float* sinks = p->in[20] + i * 16;
    ASeg sa, sb; sa.k2 = nullptr; sa.k2ld = 0; sa.k1f32 = 0; sa.kpos0 = 0; sb = sa; sb.k1 = nullptr; sb.vt = nullptr; sb.k1ld = 0; sb.vtld = 0; sb.nkeys = 0;
    const int x0 = (int)(xb_xcc_id() & 7u);
    for (int xi = 0; xi < 8; ++xi) { const int x = (x0 + xi) & 7; unsigned* ctr = (unsigned*)(p->ws + WS_CTL) + ((2 * i + 1) * 8 + x) * 16;
    for (;;) {
        const int id = next_item(ctr, lane);
        if (id >= 2080) break;
        if (id < 32) {
            const int b = x + 8 * (id >> 3), r = id & 7, kvh = r >> 2, hq0 = kvh * 8 + (r & 3) * 2; const size_t rn = (size_t)TP + b * 32;
            sa.k1 = p->in[6] + ((size_t)(i * 32 + b) * 128) * 128 + kvh * 64; sa.k1ld = 128; sa.k1f32 = 1; sa.vt = VTCC + ((size_t)(i * 32 + b) * 128 + kvh * 64) * 128; sa.vtld = 128; sa.nkeys = 128;
            sb.k1 = P + rn * 1280 + 1024 + kvh * 64; sb.k1ld = 1280; sb.k1f32 = 0; sb.vt = VTC + (size_t)(kvh * 64) * T + rn; sb.vtld = T; sb.nkeys = 32;
            const bf16_t* q = P + rn * 1280 + hq0 * 64; bf16_t* o = HO + rn * 1024 + hq0 * 64;
            attn_item<2, 4, true>(q, q + 64, 1280, 2, sa, sb, 0.125f, tbl, false, 0, true, sinks[hq0], sinks[hq0 + 1], o, o + 64, 1024, lane, qbuf, ropeA);
        } else {
            const int e = id - 32, r = e & 511, c = 8 * (3 - (e >> 9)) + 7 - (r & 7), pr = r >> 3, b = x + 8 * (pr >> 4), hq = pr & 15, kvh = hq >> 3; const size_t r0 = (size_t)b * 2048; const int ks = (c > 2 ? c - 2 : 0) * 64;
            sa.k1 = P + (r0 + ks) * 1280 + 1024 + kvh * 64; sa.k1ld = 1280; sa.k1f32 = 0; sa.vt = VTC + (size_t)(kvh * 64) * T + r0 + ks; sa.vtld = T; sa.nkeys = (c + 1) * 64 - ks;
            const bf16_t* q = P + (r0 + c * 64) * 1280 + hq * 64; bf16_t* o = HO + (r0 + c * 64) * 1024 + hq * 64;
            attn_item<2, 4, true>(q, q + 32 * 1280, 1280, 1, sa, sb, 0.125f, tbl, false, 0, true, sinks[hq], sinks[hq], o, o + 32 * 1024, 1024, lane, qbuf, ropeA);
        }
    }
    }
}

struct GJob { const bf16_t* A; const bf16_t* Bt; bf16_t* O; int M, N, K, lda, ldb, ldc, epi; };

DI int n_gjobs(int l, int s) { if (s == 3) return 2; if (s == 5) return (l & 1) ? 0 : 5; if (s == 1 || s == 10) return 12; if (s == 7) return 5; return 1; }

DI GJob make_gjob(KP p, int l, int s, int j) {
    GJob g; unsigned char* ws = p->ws; bf16_t* W = (bf16_t*)(ws + WS_W); const int i = l >> 1; const bool odd = l & 1;
    bf16_t* HO = (bf16_t*)(ws + WS_HO); bf16_t* P = (bf16_t*)(ws + WS_P);
    bf16_t* WM = odd ? W + W_ODB + i * W_OD : W + W_EVB + i * W_EV;
    g.epi = 0;
    if (s == 0 || s == 9) { const int lf = l * 2 + (s == 9); g.A = HO; g.Bt = W + lf * W_FFN + W_GU; g.O = (bf16_t*)(ws + WS_HH); g.M = T; g.N = 2 * DFF; g.K = DM; g.lda = DM; g.ldb = DM; g.ldc = DFF; g.epi = 1; }
    else if (s == 1 || s == 10) { const int lf = l * 2 + (s == 10); g.A = (bf16_t*)(ws + WS_HH); g.Bt = W + lf * W_FFN + W_D; g.O = (bf16_t*)(ws + WS_RF); g.M = TP; g.N = DM; g.K = DFF; g.lda = DFF; g.ldb = DFF; g.ldc = DM;
        if (j > 0) { g.A += (size_t)TP * DFF + (j - 1) * 256; g.Bt += (j - 1) * 256; g.O = (bf16_t*)(ws + WS_RSF) + (size_t)(j - 1) * TS * DM; g.M = TS; g.K = 256; } }
    else if (s == 3) {
        if (j == 0) { g.A = HO; g.Bt = WM + (odd ? WO_IN : WE_IN); g.O = P; g.M = T; g.N = odd ? 1280 : 2048; g.K = DM; g.lda = DM; g.ldb = DM; g.ldc = g.N; }
        else { g.A = WM + (odd ? WO_INV : WE_INV); g.Bt = HO; g.O = (bf16_t*)(ws + WS_VTB); g.M = odd ? 256 : 512; g.N = T; g.K = DM; g.lda = DM; g.ldb = DM; g.ldc = T; }
    } else if (s == 5) {
        bf16_t* CK = (bf16_t*)(ws + WS_CKVC) + (size_t)i * 32768 * 128;
        if (j == 0) { g.A = P; g.Bt = WM + WE_UQ; g.O = (bf16_t*)(ws + WS_QA); g.M = T; g.N = 768; g.K = 256; g.lda = 2048; g.ldb = 256; g.ldc = 768; }
        else if (j == 1) { g.A = P + 256; g.Bt = WM + WE_UK; g.O = (bf16_t*)(ws + WS_KN); g.M = T; g.N = 512; g.K = 256; g.lda = 2048; g.ldb = 256; g.ldc = 512; }
        else if (j == 2) { g.A = WM + WE_UV; g.Bt = P + 256; g.O = (bf16_t*)(ws + WS_VTA); g.M = 512; g.N = T; g.K = 256; g.lda = 256; g.ldb = 2048; g.ldc = T; }
        else if (j == 3) { g.A = CK; g.Bt = WM + WE_UK; g.O = (bf16_t*)(ws + WS_KNC); g.M = 32768; g.N = 512; g.K = 256; g.lda = 128; g.ldb = 256; g.ldc = 512; }
        else { g.A = WM + WE_UV; g.Bt = CK; g.O = (bf16_t*)(ws + WS_VTAC); g.M = 512; g.N = 32768; g.K = 256; g.lda = 256; g.ldb = 128; g.ldc = 32768; }
    } else { g.A = HO; g.Bt = WM + (odd ? WO_OUT : WE_OUT); g.O = (bf16_t*)(ws + WS_RM); g.M = TP; g.N = DM; g.K = DM; g.lda = DM; g.ldb = DM; g.ldc = DM;
        if (j > 0) { g.A += (size_t)TP * DM + (j - 1) * 256; g.Bt += (j - 1) * 256; g.O = (bf16_t*)(ws + WS_RSM) + (size_t)(j - 1) * TS * DM; g.M = TS; g.K = 256; } }
    return g;
}

DI void run_gemms(const int TID, const int BID, KP p, int l, int s, LAS unsigned char* lds) {
    const int nj = n_gjobs(l, s), G = gridDim.x; int rot = 0;
    for (int j = 0; j < nj; ++j) {
        const GJob gj = make_gjob(p, l, s, j);
        pg8::Gemm g; g.A = gj.A; g.Bt = gj.Bt; g.M = gj.M; g.N = gj.N; g.K = gj.K; g.lda = gj.lda; g.ldb = gj.ldb;
        pg8::StaticOrder S; int c = BID - rot; if (c < 0) c += G; S.init(gj.M, gj.N, G, c);
        if (gj.epi == 0) { pg8::EpiStore E; E.O = gj.O; E.ldc = gj.ldc; pg8::gemm_phase(TID, lds, g, S, E); }
        else { pg8::EpiSwiGLU E; E.O = gj.O; pg8::gemm_phase(TID, lds, g, S, E); }
        rot = (rot + S.nwg) % G;
    }
}

DI void phase0(const int TID, const int BID, KP p, LAS unsigned char* lds) {
    const size_t gtid = (size_t)BID * 512 + TID, gn = (size_t)gridDim.x * 512;
    {   f32x2* ra = (f32x2*)(p->ws + WS_ROPEA); f32x2* rc = (f32x2*)(p->ws + WS_ROPEC);
        for (size_t e = gtid; e < 2048 * 24; e += gn) { if (e < 2048 * 16) ra[e] = rope_entry((int)(e >> 4), (int)(e & 15), p->c16); else { const size_t f = e - 2048 * 16; rc[f] = rope_entry((int)(f >> 3), (int)(f & 7), p->c8); } } }
    {   bf16_t* ck = (bf16_t*)(p->ws + WS_CKVC); const float* s = p->in[2];
        for (size_t e = gtid; e < (size_t)2 * 32768 * 128 / 4; e += gn) { const f32x4 v = *(const f32x4*)(s + 4 * e); u32x2 w; w.x = pk_bf16(v[0], v[1]); w.y = pk_bf16(v[2], v[3]); *(u32x2*)(ck + 4 * e) = w; }
        if (gtid < 256) ck[(size_t)2 * 32768 * 128 + gtid] = 0;
        bf16_t* kp = (bf16_t*)(p->ws + WS_KPEC); const float* s2 = p->in[3];
        for (size_t e = gtid; e < (size_t)2 * 32768 * 32 / 4; e += gn) { const f32x4 v = *(const f32x4*)(s2 + 4 * e); u32x2 w; w.x = pk_bf16(v[0], v[1]); w.y = pk_bf16(v[2], v[3]); *(u32x2*)(kp + 4 * e) = w; } }
    int rot = 0;
    for (int jdx = 0; jdx < 36; ++jdx) { const TJ j = make_tj(p, jdx); tj_run(TID, BID, j, rot, (LAS float*)lds); }
    norm_phase(TID, BID, p, nullptr, nullptr, 0, nullptr, 0.f, p->in[8], true);
}

DI void run_step(const int TID, const int BID, KP p, int l, int s, LAS unsigned char* lds) {
    const float* g = p->in[8] + (size_t)l * 6 * DM; const int i = l >> 1; const bool odd = l & 1;
    if (s == 2) norm_phase(TID, BID, p, (const bf16_t*)(p->ws + WS_RF), (const bf16_t*)(p->ws + WS_RSF), 11, g + DM, 0.5f, g + 2 * DM, false);
    else if (s == 8) norm_phase(TID, BID, p, (const bf16_t*)(p->ws + WS_RM), (const bf16_t*)(p->ws + WS_RSM), 4, g + 3 * DM, 1.0f, g + 4 * DM, false);
    else if (s == 11) norm_phase(TID, BID, p, (const bf16_t*)(p->ws + WS_RF), (const bf16_t*)(p->ws + WS_RSF), 11, g + 5 * DM, 0.5f, l < 3 ? g + 6 * DM : nullptr, false);
    else if (s == 4) { if (odd) post_odd(TID, BID, p, i); else post_even(TID, BID, p, i); }
    else if (s == 6) { if (odd) attn_odd(TID, p, i, lds); else attn_even(TID, p, i, lds); }
    else run_gemms(TID, BID, p, l, s, lds);
}

__global__ void __launch_bounds__(512, 2) mega(Params p) {
    extern __shared__ __attribute__((aligned(16))) unsigned char shm[];
    LAS unsigned char* lds = (LAS unsigned char*)shm;
    cg::grid_group grid = cg::this_grid();
    const int ph_lo = p.ph_lo, ph_hi = p.ph_hi;
    volatile LAS unsigned* stw = (volatile LAS unsigned*)(lds + 131072);
    if (threadIdx.x < 4) stw[threadIdx.x] = 0u;
    __syncthreads();
    for (int ph = ph_lo; ph < ph_hi; ++ph) {
        KP kp = (KP)__builtin_amdgcn_kernarg_segment_ptr();
        asm volatile("" : "+s"(kp));
        int TID = threadIdx.x, BID = blockIdx.x;
        asm volatile("" : "+v"(TID)); asm volatile("" : "+s"(BID));
        if (ph == 0) phase0(TID, BID, kp, lds);
        else if (ph == NPH - 1) {
            const f32x4* src = (const f32x4*)(kp->ws + WS_HH); f32x4* dst = (f32x4*)kp->out;
            for (size_t e = (size_t)(T / 2) * DM / 4 + (size_t)BID * 512 + TID; e < (size_t)T * DM / 4; e += (size_t)gridDim.x * 512) dst[e] = src[e];
        }
        else run_step(TID, BID, kp, (ph - 1) / 12, (ph - 1) % 12, lds);
        const bool empty_step = ph > 0 && ph < NPH - 1 && ((ph - 1) % 12) == 5 && (((ph - 1) / 12) & 1);
        if (ph + 1 < ph_hi && !empty_step) {
            unsigned* bar = (unsigned*)(kp->ws + WS_BAR);
            if (ph == 0) { grid.sync(); if (threadIdx.x == 0) (void)xb_add(&bar[XB_XCNT(xb_xcc_id())], 1u); }
            else xcd_barrier(bar, stw);
        }
    }
}

#ifndef N_LAUNCH_MODE
#define N_LAUNCH_MODE 1
#endif

extern "C" void kernel_launch(void* const* d_in, const int* in_sizes, int n_in, void* d_out, int out_size, void* d_ws, size_t ws_size, hipStream_t stream) {
    constexpr size_t kDynLds = 131072 + 16;
    static int grid_blocks = 0;
    if (!grid_blocks) {
        int dev = 0, cus = 0, per_cu = 0;
        (void)hipGetDevice(&dev);
        (void)hipDeviceGetAttribute(&cus, hipDeviceAttributeMultiprocessorCount, dev);
        (void)hipFuncSetAttribute((const void*)mega, hipFuncAttributeMaxDynamicSharedMemorySize, (int)kDynLds);
        if (hipOccupancyMaxActiveBlocksPerMultiprocessor(&per_cu, (const void*)mega, 512, kDynLds) != hipSuccess || per_cu < 1) per_cu = 1;
        (void)hipGetLastError();
        grid_blocks = cus * 1;
        if (n_in != 22 || (size_t)out_size != O_END || ws_size < WS_END) fprintf(stderr, "kernel_launch: unexpected sizes n_in %d out %d ws %zu (need %zu)\n", n_in, out_size, ws_size, (size_t)WS_END);
    }
    (void)hipMemsetAsync((char*)d_ws + WS_BAR, 0, 16384 + 4096, stream);
    Params p{};
    for (int i = 0; i < 22; ++i) p.in[i] = (const float*)d_in[i];
    p.out = (float*)d_out; p.ws = (unsigned char*)d_ws;
    p.c16 = std::pow(500000.0, -1.0 / 16.0); p.c8 = std::pow(500000.0, -1.0 / 8.0);
#if N_LAUNCH_MODE
    p.ph_lo = 0; p.ph_hi = NPH;
    void* args[] = {&p};
    hipError_t e = hipLaunchCooperativeKernel((const void*)mega, dim3(grid_blocks), dim3(512), args, kDynLds, stream);
    if (e != hipSuccess) fprintf(stderr, "cooperative launch failed: %s (grid %d)\n", hipGetErrorString(e), grid_blocks);
#else
    for (int ph = 0; ph < NPH; ++ph) {
        p.ph_lo = ph; p.ph_hi = ph + 1;
        void* args[] = {&p};
        hipError_t e = hipLaunchCooperativeKernel((const void*)mega, dim3(grid_blocks), dim3(512), args, kDynLds, stream);
        if (e != hipSuccess) { fprintf(stderr, "launch failed: %s\n", hipGetErrorString(e)); break; }
    }
#endif
}
```
